# Optimizing an MI355X kernel written in HIP

```python
import jax, jax.numpy as jnp
from jax import lax
import numpy as np

D_MODEL = 1024
BATCH = 4
SEQ = 4096
DEPTH = 4

HEAD_DIM = 64
A_HEADS = 8
A_KV_HEADS = 2
A_WIDTH = A_HEADS * HEAD_DIM
A_KV_WIDTH = A_KV_HEADS * HEAD_DIM
IDX_HEADS = 4
IDX_DIM = 64
IDX_SCALE = (IDX_HEADS * IDX_DIM) ** -0.5
TOPK_MAX = 256
POOL_WINDOWS = (2, 4, 8, 16)
POOL_GROUP = 128
POOL_WIDTH = POOL_GROUP * len(POOL_WINDOWS)
EVEN_MIX_WIDTH = A_WIDTH + POOL_WIDTH
EVEN_IN_COLS = A_WIDTH + 2 * A_KV_WIDTH + IDX_HEADS * IDX_DIM + IDX_DIM + IDX_HEADS + POOL_WIDTH
C_HEADS = 16
C_WIDTH = C_HEADS * HEAD_DIM
D_FF = -(-8 * D_MODEL // (3 * 256)) * 256
N_EVEN = (DEPTH + 1) // 2
N_ODD = DEPTH // 2
Q_BLOCK = 128
EPS = 1e-6

kernel_name = "hybrid_dsa_pool_stickbreak_trunk"


def rms_norm(x, g):
    x32 = x.astype(jnp.float32)
    y = x32 * lax.rsqrt(jnp.mean(x32 * x32, axis=-1, keepdims=True) + EPS)
    return (y * g.astype(jnp.float32)).astype(x.dtype)


def to_blocks(a):
    b, t = a.shape[:2]
    a = a.reshape((b, t // Q_BLOCK, Q_BLOCK) + a.shape[2:])
    return jnp.moveaxis(a, 1, 0)


def from_blocks(a):
    a = jnp.moveaxis(a, 0, 1)
    return a.reshape((a.shape[0], a.shape[1] * a.shape[2]) + a.shape[3:])


def dsa_attention(q, k, v, q_idx, k_idx, w_idx):
    b, t = q.shape[:2]
    n_sel = min(TOPK_MAX, t // 4)
    rep = A_HEADS // A_KV_HEADS
    key_pos = jnp.arange(t)
    gather = jax.vmap(lambda kv, ids: kv[ids])

    def block(args):
        qb, qib, wb, start = args
        q_pos = start + jnp.arange(Q_BLOCK)
        causal = key_pos[None, :] <= q_pos[:, None]
        rel = jax.nn.relu(jnp.einsum('bthd,bsd->bths', qib, k_idx).astype(jnp.float32))
        score = jnp.einsum('bths,bth->bts', rel, wb.astype(jnp.float32)) * IDX_SCALE
        score = jnp.where(causal[None], score, -jnp.inf)
        _, sel = lax.top_k(score, n_sel)
        k_sel = gather(k, sel)
        v_sel = gather(v, sel)
        valid = sel <= q_pos[None, :, None]
        qg = qb.reshape(b, Q_BLOCK, A_KV_HEADS, rep, HEAD_DIM)
        logits = jnp.einsum('btgrd,btkgd->btgrk', qg, k_sel).astype(jnp.float32) * (HEAD_DIM ** -0.5)
        logits = jnp.where(valid[:, :, None, None, :], logits, -jnp.inf)
        p = jax.nn.softmax(logits, axis=-1).astype(v.dtype)
        o = jnp.einsum('btgrk,btkgd->btgrd', p, v_sel)
        return o.reshape(b, Q_BLOCK, A_WIDTH)

    starts = jnp.arange(t // Q_BLOCK) * Q_BLOCK
    out = lax.map(block, (to_blocks(q), to_blocks(q_idx), to_blocks(w_idx), starts))
    return from_blocks(out)


def multiscale_pool(u, pool_w, pool_scale):
    b, t, _ = u.shape
    groups = u.astype(jnp.float32).reshape(b, t, len(POOL_WINDOWS), POOL_GROUP)
    c0 = jnp.pad(jnp.cumsum(groups, axis=1), ((0, 0), (1, 0), (0, 0), (0, 0)))
    pos = jnp.arange(1, t + 1, dtype=jnp.float32)
    outs = []
    for g, w in enumerate(POOL_WINDOWS):
        cg = c0[:, :, g]
        hi = cg[:, 1:]
        lo = jnp.pad(cg[:, :t + 1 - w], ((0, 0), (w - 1, 0), (0, 0)))
        count = jnp.minimum(pos, float(w))[None, :, None]
        outs.append((hi - lo) / count - groups[:, :, g])
    mixed = jnp.stack(outs, axis=2)
    y = jnp.einsum('btgc,gcd->btgd', mixed, pool_w.astype(jnp.float32))
    return (y.reshape(b, t, POOL_WIDTH) * pool_scale.astype(jnp.float32)).astype(u.dtype)


def stick_breaking_attention(q, k, v):
    b, t = q.shape[:2]
    key_pos = jnp.arange(t)

    def block(args):
        qb, start = args
        q_pos = start + jnp.arange(Q_BLOCK)
        strict = key_pos[None, :] < q_pos[:, None]
        z = jnp.einsum('bthd,bshd->bhts', qb, k).astype(jnp.float32) * (HEAD_DIM ** -0.5)
        brk = jnp.where(strict, jax.nn.softplus(z), 0.0)
        later = jnp.pad(brk[..., 1:], ((0, 0), (0, 0), (0, 0), (0, 1)))
        remain = lax.cumsum(later, axis=3, reverse=True)
        log_a = jax.nn.log_sigmoid(z) - remain
        a = jnp.where(strict, jnp.exp(log_a), 0.0).astype(v.dtype)
        o = jnp.einsum('bhts,bshd->bthd', a, v)
        return o.reshape(b, Q_BLOCK, C_WIDTH)

    starts = jnp.arange(t // Q_BLOCK) * Q_BLOCK
    out = lax.map(block, (to_blocks(q), starts))
    return from_blocks(out)


def even_mixer(h, w_in, w_out, q_g, k_g, pool_w, pool_scale):
    b, t, _ = h.shape
    proj = h @ w_in
    sizes = [A_WIDTH, A_KV_WIDTH, A_KV_WIDTH, IDX_HEADS * IDX_DIM, IDX_DIM, IDX_HEADS]
    offsets = np.cumsum(sizes).tolist()
    q, k, v, qi, ki, wi, u = jnp.split(proj, offsets, axis=-1)
    q = rms_norm(q.reshape(b, t, A_HEADS, HEAD_DIM), q_g)
    k = rms_norm(k.reshape(b, t, A_KV_HEADS, HEAD_DIM), k_g)
    v = v.reshape(b, t, A_KV_HEADS, HEAD_DIM)
    attn = dsa_attention(q, k, v, qi.reshape(b, t, IDX_HEADS, IDX_DIM), ki, wi)
    pooled = multiscale_pool(u, pool_w, pool_scale)
    return jnp.concatenate([attn, pooled], axis=-1) @ w_out


def odd_mixer(h, w_qkv, w_out):
    b, t, _ = h.shape
    q, k, v = jnp.split((h @ w_qkv).reshape(b, t, 3, C_HEADS, HEAD_DIM), 3, axis=2)
    o = stick_breaking_attention(q[:, :, 0], k[:, :, 0], v[:, :, 0])
    return o @ w_out


def swiglu(h, w1, w3, w2):
    return (jax.nn.silu(h @ w1) * (h @ w3)) @ w2


def setup_inputs(seed: int = 0) -> dict:
    key = jax.random.key(seed)
    ks = jax.random.split(key, 16)
    f32 = jnp.float32

    def dense(k, shape):
        return jax.random.normal(k, shape, f32) * (shape[-2] ** -0.5)

    def gain(k, shape, s):
        return 1.0 + s * jax.random.normal(k, shape, f32)

    return {
        'x': jax.random.normal(ks[0], (BATCH, SEQ, D_MODEL), f32),
        'norm_mix_g': gain(ks[1], (DEPTH, D_MODEL), 0.05),
        'norm_ffn_g': gain(ks[2], (DEPTH, D_MODEL), 0.05),
        'ev_w_in': dense(ks[3], (N_EVEN, D_MODEL, EVEN_IN_COLS)),
        'ev_w_out': dense(ks[4], (N_EVEN, EVEN_MIX_WIDTH, D_MODEL)),
        'ev_q_norm_g': gain(ks[5], (N_EVEN, HEAD_DIM), 0.05),
        'ev_k_norm_g': gain(ks[6], (N_EVEN, HEAD_DIM), 0.05),
        'ev_pool_w': dense(ks[7], (N_EVEN, len(POOL_WINDOWS), POOL_GROUP, POOL_GROUP)),
        'ev_pool_scale': gain(ks[8], (N_EVEN, POOL_WIDTH), 0.1),
        'od_w_qkv': dense(ks[9], (N_ODD, D_MODEL, 3 * C_WIDTH)),
        'od_w_out': dense(ks[10], (N_ODD, C_WIDTH, D_MODEL)),
        'ffn_w1': dense(ks[11], (DEPTH, D_MODEL, D_FF)),
        'ffn_w3': dense(ks[12], (DEPTH, D_MODEL, D_FF)),
        'ffn_w2': dense(ks[13], (DEPTH, D_FF, D_MODEL)),
    }


def reference(x, norm_mix_g, norm_ffn_g, ev_w_in, ev_w_out, ev_q_norm_g, ev_k_norm_g,
              ev_pool_w, ev_pool_scale, od_w_qkv, od_w_out, ffn_w1, ffn_w3, ffn_w2):
    for layer in range(DEPTH):
        i = layer // 2
        h = rms_norm(x, norm_mix_g[layer])
        if layer % 2 == 0:
            x = x + even_mixer(h, ev_w_in[i], ev_w_out[i], ev_q_norm_g[i], ev_k_norm_g[i],
                               ev_pool_w[i], ev_pool_scale[i])
        else:
            x = x + odd_mixer(h, od_w_qkv[i], od_w_out[i])
        h = rms_norm(x, norm_ffn_g[layer])
        x = x + swiglu(h, ffn_w1[layer], ffn_w3[layer], ffn_w2[layer])
    return x
```

```cpp
#include <hip/hip_runtime.h>
#include <hip/hip_bf16.h>
#include <cstdio>
#include <cstdint>

#define LAS __attribute__((address_space(3)))
#define GAS __attribute__((address_space(1)))
typedef unsigned short bf16_t;
typedef short bf16x8 __attribute__((ext_vector_type(8)));
typedef short s16x4 __attribute__((ext_vector_type(4)));
typedef float f32x4 __attribute__((ext_vector_type(4)));
typedef float f32x2 __attribute__((ext_vector_type(2)));
typedef float f32x16 __attribute__((ext_vector_type(16)));
typedef unsigned u32x4 __attribute__((ext_vector_type(4)));
typedef unsigned u32x2 __attribute__((ext_vector_type(2)));

__device__ __forceinline__ float sum_rows4(float v) {
    const auto a = __builtin_amdgcn_permlane16_swap(__float_as_uint(v), __float_as_uint(v), false, false); const float s = __uint_as_float(a[0]) + __uint_as_float(a[1]);
    const auto b = __builtin_amdgcn_permlane32_swap(__float_as_uint(s), __float_as_uint(s), false, false); return __uint_as_float(b[0]) + __uint_as_float(b[1]);
}
__device__ __forceinline__ float shfl_xor_f(float v, int mask, int lane) { return __int_as_float(__builtin_amdgcn_ds_bpermute((lane ^ mask) << 2, __float_as_int(v))); }
__device__ __forceinline__ unsigned shfl_up_u(unsigned v, int o, int lane) { return (unsigned)__builtin_amdgcn_ds_bpermute(((lane >= o) ? lane - o : lane) << 2, (int)v); }
__device__ __forceinline__ int lane_id() { return (int)__builtin_amdgcn_mbcnt_hi(~0u, __builtin_amdgcn_mbcnt_lo(~0u, 0u)); }
constexpr int NB = 4, T = 4096, D = 1024, M = NB * T, FF = 2816, DEPTH = 4;
constexpr int EIN_SRC = 1604, EIN = 1792;
constexpr float EPS = 1e-6f;
constexpr float C2 = 0.125f * 1.4426950408889634f;

constexpr size_t MiB = 1u << 20;
constexpr size_t WS_CTL = 0, CTL_ZERO_BYTES = 65536;
constexpr size_t WS_W = 1 * MiB;
constexpr size_t SZ_EIN = (size_t)EIN * D * 2, SZ_SQ = (size_t)D * D * 2, SZ_OQKV = (size_t)3 * D * D * 2, SZ_UP = (size_t)2 * FF * D * 2, SZ_DN = (size_t)D * FF * 2;
constexpr size_t WS_W_EIN = WS_W;
constexpr size_t WS_W_EOUT = WS_W_EIN + 2 * SZ_EIN;
constexpr size_t WS_W_OQKV = WS_W_EOUT + 2 * SZ_SQ;
constexpr size_t WS_W_OOUT = WS_W_OQKV + 2 * SZ_OQKV;
constexpr size_t WS_W_UP = WS_W_OOUT + 2 * SZ_SQ;
constexpr size_t WS_W_DN = WS_W_UP + 4 * SZ_UP;
constexpr size_t WS_W_END = WS_W_DN + 4 * SZ_DN;
static_assert(WS_W_END == 94 * MiB, "weights");
constexpr size_t WS_XB = 94 * MiB;
constexpr size_t WS_SSP = 126 * MiB;
constexpr size_t WS_MASK = 127 * MiB;
constexpr size_t WS_ACT = 135 * MiB;
constexpr size_t WS_EQ = WS_ACT;
constexpr size_t WS_EK = WS_EQ + (size_t)M * 512 * 2;
constexpr size_t WS_EV = WS_EK + (size_t)M * 128 * 2;
constexpr size_t WS_EQI = WS_EV + (size_t)M * 128 * 2;
constexpr size_t WS_EKI = WS_EQI + (size_t)M * 256 * 2;
constexpr size_t WS_EWI = WS_EKI + (size_t)M * 64 * 2;
constexpr size_t WS_EU = WS_EWI + (size_t)M * 4 * 4;
constexpr size_t WS_EMIX = WS_EU + (size_t)M * 512 * 2;
constexpr size_t WS_OQ = WS_ACT;
constexpr size_t WS_OK = WS_OQ + (size_t)M * D * 2;
constexpr size_t WS_OV = WS_OK + (size_t)M * D * 2;
constexpr size_t WS_H2 = WS_ACT;
constexpr size_t WS_SW = 256 * 1024;
constexpr size_t WS_SWQ = 512 * 1024;
constexpr size_t WS_XQ = 224 * MiB;
constexpr size_t WS_SAR = 240 * MiB;
constexpr size_t WS_XQ1 = 232 * MiB;
constexpr size_t WS_SAR1 = 248 * MiB;
constexpr size_t WS_END = 256 * MiB;
static_assert(WS_OV + (size_t)M * D * 2 <= WS_XQ1 && WS_XQ1 + (size_t)M * D <= WS_SAR1 && WS_SAR1 + (size_t)M * 4 <= WS_END, "ws map (QKV quantisation)");
static_assert(WS_EMIX + (size_t)M * D * 2 <= WS_XQ && WS_OV + (size_t)M * D * 2 <= WS_END && WS_H2 + (size_t)M * FF * 2 <= WS_XQ && WS_XQ + (size_t)M * D <= WS_SAR && WS_SAR + (size_t)M * 4 <= WS_END && WS_SW + 4 * 2 * FF * 4 <= WS_SWQ && WS_SWQ + 2 * 3 * D * 4 <= MiB, "ws map");

constexpr int RING_BYTES = 131072;
constexpr int TAB_OFF = RING_BYTES;
constexpr int LDSCTL_OFF = TAB_OFF + 2048, MISC_OFF = LDSCTL_OFF + 320;
constexpr int LDS_BYTES = 147456;

__device__ __forceinline__ void st16_wt(void* p, u32x4 v) { asm volatile("global_store_dwordx4 %0, %1, off sc1\n\ts_nop 1" :: "v"(p), "v"(v) : "memory"); }
__device__ __forceinline__ void st8_wt(void* p, u32x2 v) { asm volatile("global_store_dwordx2 %0, %1, off sc1\n\ts_nop 1" :: "v"(p), "v"(v) : "memory"); }
namespace pg8 {
constexpr int BM = 256, BK = 64, HALF = 128, HTB = HALF * BK * 2, STAGE_BYTES = 8 * HTB, NXCD = 8, WGM = 8;
__host__ __device__ __forceinline__ int lds_byte(int r, int c) { const int st = (r >> 4) * 2 + (c >> 5), rr = r & 15, cc = c & 31, ob = rr * 64 + cc * 2; return st * 1024 + (ob ^ (((ob >> 9) & 1) << 5)); }
__host__ __device__ __forceinline__ void stage_rc(int b, int& R, int& C) { const int st = b / 1024, sb = b % 1024, swz = sb ^ (((sb >> 9) & 1) << 5); R = (st >> 1) * 16 + swz / 64; C = (st & 1) * 32 + (swz % 64) / 2; }
__host__ __device__ __forceinline__ int perm32(int rho) { const int n = rho >> 4, i = rho & 15; return 8 * (i >> 2) + 4 * n + (i & 3); }

struct Unit { int pm, pn; };
struct Gemm { const bf16_t* A; const bf16_t* Bt; int N, K, lda; const float* ssp; };

struct StaticOrder {
    int nM, nN, nwg, G, c;
    __device__ void init(int M_, int N, int G_, int c_) { nM = M_ / BM; nN = N / BM; nwg = nM * nN; G = G_; c = c_; }
    __device__ bool next(int i, Unit& u) const {
        const long L = (long)i * G + c; if (L >= nwg) return false;
        int wgid = (int)L; { const int q = nwg / NXCD, r = nwg % NXCD, xcd = wgid % NXCD, off = wgid / NXCD; wgid = (xcd < r ? xcd * (q + 1) : r * (q + 1) + (xcd - r) * q) + off; }
        const int nig = WGM * nN, gid = wgid / nig, fm = gid * WGM, gsz = (nM - fm) < WGM ? (nM - fm) : WGM;
        u.pm = fm + ((wgid % nig) % gsz); u.pn = (wgid % nig) / gsz; return true;
    }
};

__device__ __forceinline__ unsigned cvt_pk_bf16(float lo, float hi) { unsigned r; asm volatile("v_cvt_pk_bf16_f32 %0, %1, %2" : "=v"(r) : "v"(lo), "v"(hi)); return r; }

typedef f32x4 Acc[2][2][4][2];
typedef int i32x4 __attribute__((ext_vector_type(4)));
typedef i32x4 AccI[2][2][4][2];

struct EpiEvenIn {
    static constexpr bool PERM = true, NEED_RSTD = true, I8 = false; typedef f32x4 AccV;
    unsigned char* ws; const float *qg, *kg;
    __device__ __forceinline__ void operator()(const Acc& acc, const Unit& u, int wr, int wc, int fr, int fq, const LAS float* tab) const {
        const int pn = u.pn;
        bf16_t* const Q = (bf16_t*)(ws + WS_EQ); bf16_t* const K = (bf16_t*)(ws + WS_EK); bf16_t* const V = (bf16_t*)(ws + WS_EV); bf16_t* const QI = (bf16_t*)(ws + WS_EQI);
        bf16_t* const KI = (bf16_t*)(ws + WS_EKI); bf16_t* const U = (bf16_t*)(ws + WS_EU); float* const WI = (float*)(ws + WS_EWI);
        bf16_t* dst; int pitch; int mode = 0;
        if (pn < 2) { dst = Q + (4 * pn + wc) * 64; pitch = 512; mode = 1; }
        else if (pn == 2) { if (wc < 2) { dst = K + wc * 64; pitch = 128; mode = 2; } else { dst = V + (wc - 2) * 64; pitch = 128; } }
        else if (pn == 3) { dst = QI + wc * 64; pitch = 256; }
        else if (pn < 6) { dst = U + (4 * (pn - 4) + wc) * 64; pitch = 512; }
        else { dst = KI; pitch = 64; mode = (wc == 0) ? 0 : (wc == 1 ? 3 : 4); }
        if (mode == 4) return;
        f32x4 gv[2][2];
#pragma unroll
        for (int bj = 0; bj < 2; ++bj)
#pragma unroll
            for (int n = 0; n < 2; ++n) { gv[bj][n] = (f32x4){1.f, 1.f, 1.f, 1.f};
                if (mode == 1) gv[bj][n] = *(const f32x4*)(qg + 32 * bj + 8 * fq + 4 * n);
                if (mode == 2) gv[bj][n] = *(const f32x4*)(kg + 32 * bj + 8 * fq + 4 * n); }
        float rsv[2][4];
#pragma unroll
        for (int ai = 0; ai < 2; ++ai)
#pragma unroll
            for (int m = 0; m < 4; ++m) rsv[ai][m] = tab[ai * HALF + wr * 64 + m * 16 + fr];
#pragma unroll
        for (int ai = 0; ai < 2; ++ai)
#pragma unroll
            for (int m = 0; m < 4; ++m) {
                const int rl = ai * HALF + wr * 64 + m * 16 + fr; const size_t row = (size_t)u.pm * BM + rl; const float rs = rsv[ai][m];
                f32x4 v[2][2]; float ss = 0.f;
#pragma unroll
                for (int bj = 0; bj < 2; ++bj)
#pragma unroll
                    for (int n = 0; n < 2; ++n) { v[bj][n] = acc[ai][bj][m][n] * rs; const f32x4 x = v[bj][n]; ss += (x[0] * x[0] + x[1] * x[1]) + (x[2] * x[2] + x[3] * x[3]); }
                if (mode == 3) { if (fq == 0) *(f32x4*)(WI + row * 4) = v[0][0]; continue; }
                float sc = 1.f;
                if (mode == 1 || mode == 2) { ss = sum_rows4(ss); sc = rsqrtf(ss * (1.0f / 64.0f) + EPS); if (mode == 1) sc *= C2; }
#pragma unroll
                for (int bj = 0; bj < 2; ++bj) { const f32x4 a = v[bj][0] * gv[bj][0] * sc, b = v[bj][1] * gv[bj][1] * sc;
                    u32x4 w; w.x = cvt_pk_bf16(a[0], a[1]); w.y = cvt_pk_bf16(a[2], a[3]); w.z = cvt_pk_bf16(b[0], b[1]); w.w = cvt_pk_bf16(b[2], b[3]);
                    st16_wt(dst + row * pitch + 32 * bj + 8 * fq, w); }
            }
    }
};

struct EpiOddQKV {
    static constexpr bool PERM = true, NEED_RSTD = true, I8 = false; typedef f32x4 AccV;
    bf16_t* QKV;
    __device__ __forceinline__ void operator()(const Acc& acc, const Unit& u, int wr, int wc, int fr, int fq, const LAS float* tab) const {
        const int t = u.pn >> 2; const float sc0 = (t == 0) ? C2 : 1.f;
        bf16_t* base = QKV + (size_t)t * ((size_t)M * D) + (u.pn & 3) * BM + wc * 32 + 8 * fq;
        float rsv[2][4];
#pragma unroll
        for (int ai = 0; ai < 2; ++ai)
#pragma unroll
            for (int m = 0; m < 4; ++m) rsv[ai][m] = tab[ai * HALF + wr * 64 + m * 16 + fr];
#pragma unroll
        for (int ai = 0; ai < 2; ++ai)
#pragma unroll
            for (int m = 0; m < 4; ++m) {
                const int rl = ai * HALF + wr * 64 + m * 16 + fr; const size_t row = (size_t)u.pm * BM + rl; const float rs = rsv[ai][m] * sc0;
#pragma unroll
                for (int bj = 0; bj < 2; ++bj) { const f32x4 a = acc[ai][bj][m][0] * rs, b = acc[ai][bj][m][1] * rs;
                    u32x4 w; w.x = cvt_pk_bf16(a[0], a[1]); w.y = cvt_pk_bf16(a[2], a[3]); w.z = cvt_pk_bf16(b[0], b[1]); w.w = cvt_pk_bf16(b[2], b[3]);
                    st16_wt(base + row * D + bj * HALF, w); }
            }
    }
};

struct EpiOddQKVq {
    static constexpr bool PERM = true, NEED_RSTD = true, I8 = true; typedef i32x4 AccV;
    bf16_t* QKV; const float* sw;
    __device__ __forceinline__ void operator()(const AccI& acc, const Unit& u, int wr, int wc, int fr, int fq, const LAS float* tab) const {
        const int t = u.pn >> 2; const float sc0 = (t == 0) ? C2 : 1.f;
        bf16_t* base = QKV + (size_t)t * ((size_t)M * D) + (u.pn & 3) * BM + wc * 32 + 8 * fq;
        f32x4 sv[2][2];
#pragma unroll
        for (int bj = 0; bj < 2; ++bj)
#pragma unroll
            for (int n = 0; n < 2; ++n) sv[bj][n] = *(const f32x4*)(sw + u.pn * BM + bj * HALF + wc * 32 + 8 * fq + 4 * n) * sc0;
        float rsv[2][4];
#pragma unroll
        for (int ai = 0; ai < 2; ++ai)
#pragma unroll
            for (int m = 0; m < 4; ++m) rsv[ai][m] = tab[ai * HALF + wr * 64 + m * 16 + fr];
#pragma unroll
        for (int ai = 0; ai < 2; ++ai)
#pragma unroll
            for (int m = 0; m < 4; ++m) {
                const int rl = ai * HALF + wr * 64 + m * 16 + fr; const size_t row = (size_t)u.pm * BM + rl; const float rs = rsv[ai][m];
#pragma unroll
                for (int bj = 0; bj < 2; ++bj) {
                    const i32x4 ia = acc[ai][bj][m][0], ib = acc[ai][bj][m][1];
                    const f32x4 a = (f32x4){(float)ia[0], (float)ia[1], (float)ia[2], (float)ia[3]} * (sv[bj][0] * rs), b = (f32x4){(float)ib[0], (float)ib[1], (float)ib[2], (float)ib[3]} * (sv[bj][1] * rs);
                    u32x4 w; w.x = cvt_pk_bf16(a[0], a[1]); w.y = cvt_pk_bf16(a[2], a[3]); w.z = cvt_pk_bf16(b[0], b[1]); w.w = cvt_pk_bf16(b[2], b[3]);
                    st16_wt(base + row * D + bj * HALF, w); }
            }
    }
};

struct EpiSwiGLUq {
    static constexpr bool PERM = true, NEED_RSTD = true, I8 = true; typedef i32x4 AccV;
    bf16_t* H; const float* sw;
    __device__ __forceinline__ void operator()(const AccI& acc, const Unit& u, int wr, int wc, int fr, int fq, const LAS float* tab) const {
        bf16_t* base = H + u.pn * HALF + wc * 32 + 8 * fq;
        f32x4 sg[2], su[2];
#pragma unroll
        for (int n = 0; n < 2; ++n) { sg[n] = *(const f32x4*)(sw + u.pn * BM + wc * 32 + 8 * fq + 4 * n); su[n] = *(const f32x4*)(sw + u.pn * BM + HALF + wc * 32 + 8 * fq + 4 * n); }
        float rsv[2][4];
#pragma unroll
        for (int ai = 0; ai < 2; ++ai)
#pragma unroll
            for (int m = 0; m < 4; ++m) rsv[ai][m] = tab[ai * HALF + wr * 64 + m * 16 + fr];
#pragma unroll
        for (int ai = 0; ai < 2; ++ai)
#pragma unroll
            for (int m = 0; m < 4; ++m) {
                const int rl = ai * HALF + wr * 64 + m * 16 + fr; const size_t row = (size_t)u.pm * BM + rl; const float rs = rsv[ai][m];
                float o[8];
#pragma unroll
                for (int n = 0; n < 2; ++n)
#pragma unroll
                    for (int e = 0; e < 4; e += 2) {
                        const f32x2 g = (f32x2){(float)acc[ai][0][m][n][e], (float)acc[ai][0][m][n][e + 1]} * ((f32x2){sg[n][e], sg[n][e + 1]} * rs);
                        const f32x2 up = (f32x2){(float)acc[ai][1][m][n][e], (float)acc[ai][1][m][n][e + 1]} * ((f32x2){su[n][e], su[n][e + 1]} * rs);
                        f32x2 d; d.x = __builtin_amdgcn_exp2f(-g.x); d.y = __builtin_amdgcn_exp2f(-g.y); d = d + 1.0f;
                        f32x2 r; r.x = __builtin_amdgcn_rcpf(d.x); r.y = __builtin_amdgcn_rcpf(d.y); const f32x2 ov = (g * up) * r; o[4 * n + e] = ov.x; o[4 * n + e + 1] = ov.y; }
                u32x4 w; w.x = cvt_pk_bf16(o[0], o[1]); w.y = cvt_pk_bf16(o[2], o[3]); w.z = cvt_pk_bf16(o[4], o[5]); w.w = cvt_pk_bf16(o[6], o[7]);
                st16_wt(base + row * FF, w);
            }
    }
};

struct EpiRes {
    static constexpr bool PERM = true, NEED_RSTD = false, I8 = false; typedef f32x4 AccV;
    const float* base32; float* out32; unsigned char* ws; bool dry;
    __device__ __forceinline__ void operator()(const Acc& acc, const Unit& u, int wr, int wc, int fr, int fq, const LAS float* tab) const {
        bf16_t* const xb = (bf16_t*)(ws + WS_XB); float* const ssp = (float*)(ws + WS_SSP);
        const int col0 = u.pn * BM + wc * 32 + 8 * fq;
        u32x4 rb[2][4][2];
        if (!base32) {
#pragma unroll
            for (int ai = 0; ai < 2; ++ai)
#pragma unroll
                for (int m = 0; m < 4; ++m)
#pragma unroll
                    for (int bj = 0; bj < 2; ++bj) rb[ai][m][bj] = *(const u32x4*)(xb + ((size_t)u.pm * BM + ai * HALF + wr * 64 + m * 16 + fr) * D + col0 + bj * HALF);
            asm volatile("" : "+v"(rb[0][0][0]), "+v"(rb[0][0][1]), "+v"(rb[0][1][0]), "+v"(rb[0][1][1]), "+v"(rb[0][2][0]), "+v"(rb[0][2][1]), "+v"(rb[0][3][0]), "+v"(rb[0][3][1]),
                             "+v"(rb[1][0][0]), "+v"(rb[1][0][1]), "+v"(rb[1][1][0]), "+v"(rb[1][1][1]), "+v"(rb[1][2][0]), "+v"(rb[1][2][1]), "+v"(rb[1][3][0]), "+v"(rb[1][3][1]));
        }
#pragma unroll
        for (int ai = 0; ai < 2; ++ai)
#pragma unroll
            for (int m = 0; m < 4; ++m) {
                const size_t row = (size_t)u.pm * BM + ai * HALF + wr * 64 + m * 16 + fr; const size_t off = row * D + col0; float ss = 0.f;
#pragma unroll
                for (int bj = 0; bj < 2; ++bj) { f32x4 b0, b1;
                    if (base32) { b0 = *(const f32x4*)(base32 + off + bj * HALF); b1 = *(const f32x4*)(base32 + off + bj * HALF + 4); }
                    else { const u32x4 b4 = rb[ai][m][bj];
                        b0 = (f32x4){__uint_as_float(b4.x << 16), __uint_as_float(b4.x & 0xFFFF0000u), __uint_as_float(b4.y << 16), __uint_as_float(b4.y & 0xFFFF0000u)};
                        b1 = (f32x4){__uint_as_float(b4.z << 16), __uint_as_float(b4.z & 0xFFFF0000u), __uint_as_float(b4.w << 16), __uint_as_float(b4.w & 0xFFFF0000u)}; }
                    const f32x4 o0 = b0 + acc[ai][bj][m][0], o1 = b1 + acc[ai][bj][m][1];
                    if (out32 && !dry) { *(f32x4*)(out32 + off + bj * HALF) = o0; *(f32x4*)(out32 + off + bj * HALF + 4) = o1; }
                    ss += ((o0[0] * o0[0] + o0[1] * o0[1]) + (o0[2] * o0[2] + o0[3] * o0[3])) + ((o1[0] * o1[0] + o1[1] * o1[1]) + (o1[2] * o1[2] + o1[3] * o1[3]));
                    u32x4 w; w.x = cvt_pk_bf16(o0[0], o0[1]); w.y = cvt_pk_bf16(o0[2], o0[3]); w.z = cvt_pk_bf16(o1[0], o1[1]); w.w = cvt_pk_bf16(o1[2], o1[3]);
                    if (!dry) st16_wt(xb + off + bj * HALF, w); }
                ss = sum_rows4(ss);
                if (fq == 0 && !dry) ssp[row * 16 + u.pn * 4 + wc] = ss;
            }
    }
};

template <bool I8> __device__ __forceinline__ f32x4 mma16(bf16x8 b, bf16x8 a, f32x4 c) { return __builtin_amdgcn_mfma_f32_16x16x32_bf16(b, a, c, 0, 0, 0); }
template <bool I8> __device__ __forceinline__ i32x4 mma16(bf16x8 b, bf16x8 a, i32x4 c) { return __builtin_amdgcn_mfma_i32_16x16x64_i8(__builtin_bit_cast(i32x4, b), __builtin_bit_cast(i32x4, a), c, 0, 0, 0); }
template <class Epi, bool ALIGN_EPI, bool SP2>
__device__ __forceinline__ void gemm_phase(LAS unsigned char* lds, LAS float* tab, const Gemm g, const StaticOrder& S, const Epi& E, int wave_s) {
    int tid = wave_s * 64 + lane_id(); asm volatile("" : "+v"(tid));
    const int wid = __builtin_amdgcn_readfirstlane(tid >> 6), lane = tid & 63, wr = wid >> 2, wc = wid & 3, fr = lane & 15, fq = lane >> 4;
    const int K = g.K, nt = K / BK, lda = g.lda;
    unsigned voffA[2], voffB[2];
#pragma unroll
    for (int i = 0; i < 2; ++i) { int R, C; stage_rc(tid * 16 + i * 8192, R, C); const int Rb = Epi::PERM ? ((R & ~31) + perm32(R & 31)) : R;
        voffA[i] = (unsigned)(R * lda + C) * 2u; voffB[i] = (unsigned)(Rb * K + C) * 2u; }
    const size_t kstep = (size_t)(BK * 2);
    const size_t hstepA = (size_t)HALF * lda * 2, hstepB = (size_t)HALF * K * 2;
    const size_t tstepA = 2 * hstepA, tstepB = 2 * hstepB;
    const unsigned ldsw = (unsigned)wid * 1024u;
    const int aoff = lds_byte(wr * 64 + fr, fq * 8), boff = lds_byte(wc * 32 + fr, fq * 8);
#define PG8_SA(b, h) (((b) * 2 + (h)) * HTB)
#define PG8_SB(b, h) ((4 + (b) * 2 + (h)) * HTB)
#define PG8_STAGE(bufoff, gbase, voff) do { _Pragma("unroll") for (int _i = 0; _i < 2; ++_i) \
        __builtin_amdgcn_global_load_lds((const unsigned*)((const char*)(gbase) + (voff)[_i]), (LAS unsigned*)(lds + (bufoff) + ldsw + _i * 8192), 16, 0, 0); } while (0)
#define PG8_LDA(dst, b, h) do { _Pragma("unroll") for (int m = 0; m < 4; ++m) _Pragma("unroll") for (int k = 0; k < 2; ++k) dst[m][k] = *(const LAS bf16x8*)(lds + PG8_SA(b, h) + aoff + m * 2048 + k * 1024); } while (0)
#define PG8_LDB(dst, b, h) do { _Pragma("unroll") for (int n = 0; n < 2; ++n) _Pragma("unroll") for (int k = 0; k < 2; ++k) dst[n][k] = *(const LAS bf16x8*)(lds + PG8_SB(b, h) + boff + n * 2048 + k * 1024); } while (0)
#define PG8_MMA(ai, bj, At, Bt) do { __builtin_amdgcn_s_setprio(1); _Pragma("unroll") for (int m = 0; m < 4; ++m) _Pragma("unroll") for (int n = 0; n < 2; ++n) _Pragma("unroll") for (int k = 0; k < 2; ++k) \
        acc[ai][bj][m][n] = mma16<Epi::I8>(Bt[n][k], At[m][k], acc[ai][bj][m][n]); __builtin_amdgcn_s_setprio(0); } while (0)
#define PG8_WAIT_V(n) asm volatile("s_waitcnt vmcnt(" #n ")" ::: "memory")
#define PG8_WAIT_L(n) asm volatile("s_waitcnt lgkmcnt(" #n ")" ::: "memory")
#define PG8_BAR __builtin_amdgcn_s_barrier()
#define PG8_SCHED __builtin_amdgcn_sched_barrier(0)
    Unit cur, nxt; int ui = 0;
    if (!S.next(0, cur)) return;
    typedef typename Epi::AccV AccV; AccV acc[2][2][4][2];
#pragma unroll
    for (int a = 0; a < 2; ++a)
#pragma unroll
        for (int b = 0; b < 2; ++b)
#pragma unroll
            for (int m = 0; m < 4; ++m)
#pragma unroll
                for (int n = 0; n < 2; ++n) acc[a][b][m][n] = AccV{};
    bf16x8 At[4][2], B0[2][2], B1[2][2];
    const char* cA = (const char*)g.A + (size_t)cur.pm * tstepA; const char* cB = (const char*)g.Bt + (size_t)cur.pn * tstepB;
    if constexpr (SP2) {
        PG8_STAGE(PG8_SB(0, 0), cB, voffB); PG8_STAGE(PG8_SB(0, 1), cB + hstepB, voffB); PG8_STAGE(PG8_SA(0, 0), cA, voffA); PG8_STAGE(PG8_SA(0, 1), cA + hstepA, voffA);
        if (wr == 1) PG8_BAR;
        PG8_WAIT_V(2); PG8_BAR;
        PG8_STAGE(PG8_SB(1, 0), cB + kstep, voffB); PG8_STAGE(PG8_SA(1, 0), cA + kstep, voffA); PG8_STAGE(PG8_SB(1, 1), cB + hstepB + kstep, voffB);
        PG8_WAIT_V(6); PG8_BAR;
    } else {
        PG8_STAGE(PG8_SB(0, 0), cB, voffB); PG8_STAGE(PG8_SA(0, 0), cA, voffA); PG8_STAGE(PG8_SB(0, 1), cB + hstepB, voffB); PG8_STAGE(PG8_SA(0, 1), cA + hstepA, voffA);
        if (wr == 1) PG8_BAR;
        PG8_WAIT_V(4); PG8_BAR;
        PG8_STAGE(PG8_SB(1, 0), cB + kstep, voffB); PG8_STAGE(PG8_SA(1, 0), cA + kstep, voffA); PG8_STAGE(PG8_SB(1, 1), cB + hstepB + kstep, voffB);
        PG8_WAIT_V(6); PG8_BAR;
    }
    for (;;) {
        const bool has_next = S.next(ui + 1, nxt);
        if constexpr (Epi::NEED_RSTD) {
            if (Epi::I8) { if (tid < 256) tab[(ui & 1) * 256 + tid] = g.ssp[(size_t)cur.pm * BM + tid]; }
            else if (tid < 256) { const f32x4* p = (const f32x4*)(g.ssp + ((size_t)cur.pm * BM + tid) * 16); const f32x4 a = p[0], b = p[1], c = p[2], d = p[3];
                const float s = ((a[0] + a[1]) + (a[2] + a[3])) + ((b[0] + b[1]) + (b[2] + b[3])) + ((c[0] + c[1]) + (c[2] + c[3])) + ((d[0] + d[1]) + (d[2] + d[3]));
                tab[(ui & 1) * 256 + tid] = rsqrtf(s * (1.0f / D) + EPS); }
        }
        const char* nA = has_next ? (const char*)g.A + (size_t)nxt.pm * tstepA : cA; const char* nB = has_next ? (const char*)g.Bt + (size_t)nxt.pn * tstepB : cB;
        for (int t = 0; t < nt; t += 2) {
            const bool last = (t == nt - 2);
            const char* a1 = cA + (size_t)(t + 1) * kstep;
            const char* a2 = last ? nA : cA + (size_t)(t + 2) * kstep; const char* b2 = last ? nB : cB + (size_t)(t + 2) * kstep;
            const char* a3 = a2 + kstep; const char* b3 = b2 + kstep;
            if constexpr (SP2) {
            PG8_LDB(B0, 0, 0); PG8_LDB(B1, 0, 1); PG8_SCHED; PG8_LDA(At, 0, 0); PG8_STAGE(PG8_SA(1, 1), a1 + hstepA, voffA);
            PG8_WAIT_V(8); PG8_WAIT_L(0); PG8_BAR; PG8_MMA(0, 0, At, B0); PG8_MMA(0, 1, At, B1); PG8_BAR; PG8_SCHED;
            PG8_LDA(At, 0, 1); PG8_STAGE(PG8_SB(0, 0), b2, voffB); PG8_STAGE(PG8_SB(0, 1), b2 + hstepB, voffB); PG8_STAGE(PG8_SA(0, 0), a2, voffA);
            PG8_WAIT_V(8); PG8_WAIT_L(0); PG8_BAR; PG8_MMA(1, 0, At, B0); PG8_MMA(1, 1, At, B1); PG8_BAR; PG8_SCHED;
            PG8_LDB(B0, 1, 0); PG8_LDB(B1, 1, 1); PG8_SCHED; PG8_LDA(At, 1, 0); PG8_STAGE(PG8_SA(0, 1), a2 + hstepA, voffA);
            PG8_WAIT_V(8); PG8_WAIT_L(0); PG8_BAR; PG8_MMA(0, 0, At, B0); PG8_MMA(0, 1, At, B1); PG8_BAR; PG8_SCHED;
            PG8_LDA(At, 1, 1); PG8_STAGE(PG8_SB(1, 0), b3, voffB); PG8_STAGE(PG8_SB(1, 1), b3 + hstepB, voffB); PG8_STAGE(PG8_SA(1, 0), a3, voffA);
            PG8_WAIT_V(8); PG8_WAIT_L(0); PG8_BAR; PG8_MMA(1, 0, At, B0); PG8_MMA(1, 1, At, B1); PG8_BAR; PG8_SCHED;
            } else {
            PG8_LDB(B0, 0, 0); PG8_SCHED; PG8_LDA(At, 0, 0); PG8_STAGE(PG8_SA(1, 1), a1 + hstepA, voffA);
            PG8_WAIT_L(8); PG8_BAR; PG8_WAIT_L(0); PG8_MMA(0, 0, At, B0); PG8_BAR; PG8_SCHED;
            PG8_LDB(B1, 0, 1); PG8_STAGE(PG8_SB(0, 0), b2, voffB);
            PG8_BAR; PG8_WAIT_L(0); PG8_MMA(0, 1, At, B1); PG8_BAR;
            PG8_LDA(At, 0, 1); PG8_STAGE(PG8_SA(0, 0), a2, voffA);
            PG8_BAR; PG8_WAIT_L(0); PG8_MMA(1, 0, At, B0); PG8_BAR; PG8_SCHED;
            PG8_STAGE(PG8_SB(0, 1), b2 + hstepB, voffB);
            PG8_WAIT_V(6); PG8_BAR; PG8_MMA(1, 1, At, B1); PG8_BAR;
            PG8_LDB(B0, 1, 0); PG8_SCHED; PG8_LDA(At, 1, 0); PG8_STAGE(PG8_SA(0, 1), a2 + hstepA, voffA);
            PG8_WAIT_L(8); PG8_BAR; PG8_WAIT_L(0); PG8_MMA(0, 0, At, B0); PG8_BAR; PG8_SCHED;
            PG8_LDB(B1, 1, 1); PG8_STAGE(PG8_SB(1, 0), b3, voffB);
            PG8_BAR; PG8_WAIT_L(0); PG8_MMA(0, 1, At, B1); PG8_BAR;
            PG8_LDA(At, 1, 1); PG8_STAGE(PG8_SA(1, 0), a3, voffA);
            PG8_BAR; PG8_WAIT_L(0); PG8_MMA(1, 0, At, B0); PG8_BAR; PG8_SCHED;
            PG8_STAGE(PG8_SB(1, 1), b3 + hstepB, voffB);
            PG8_WAIT_V(6); PG8_BAR; PG8_MMA(1, 1, At, B1); PG8_BAR;
            }
        }
        if constexpr (ALIGN_EPI) { if (wr == 0) PG8_BAR; }
        E(acc, cur, wr, wc, fr, fq, (const LAS float*)(tab + (ui & 1) * 256));
        if (!has_next) break;
#pragma unroll
        for (int a = 0; a < 2; ++a)
#pragma unroll
            for (int b = 0; b < 2; ++b)
#pragma unroll
                for (int m = 0; m < 4; ++m)
#pragma unroll
                    for (int n = 0; n < 2; ++n) acc[a][b][m][n] = AccV{};
        cur = nxt; cA = nA; cB = nB; ++ui;
        if constexpr (ALIGN_EPI) { if (wr == 1) PG8_BAR; }
    }
    PG8_WAIT_V(0);
    if constexpr (!ALIGN_EPI) { if (wr == 0) PG8_BAR; }
    PG8_BAR;
#undef PG8_SA
#undef PG8_SB
#undef PG8_STAGE
#undef PG8_LDA
#undef PG8_LDB
#undef PG8_MMA
#undef PG8_WAIT_V
#undef PG8_WAIT_L
#undef PG8_BAR
#undef PG8_SCHED
}
}

typedef GAS unsigned gu32;
#define RLX_AGENT __ATOMIC_RELAXED, __HIP_MEMORY_SCOPE_AGENT
#define LDS_WAIT() asm volatile("s_waitcnt lgkmcnt(0)" ::: "memory")
#define VM_WAIT() asm volatile("s_waitcnt vmcnt(0)" ::: "memory")
__device__ __forceinline__ unsigned f2bf(float f) { unsigned u = __builtin_bit_cast(unsigned, f); return (u + 0x7fffu + ((u >> 16) & 1u)) >> 16; }
__device__ __forceinline__ unsigned pk2(float lo, float hi) { return f2bf(lo) | (f2bf(hi) << 16); }
__device__ __forceinline__ float bf2f(unsigned short b) { return __builtin_bit_cast(float, (unsigned)b << 16); }

#define XB_TMO      128
#define XB_XCNT(j)  (256  + 64 * (j))
#define XB_XSUB(j)  (1280 + 64 * (j))
#define XB_XGEN(j)  (2304 + 64 * (j))
#define XB_TOP      3328
#define XB_TOPGEN   3392
#define XCD_BAR_WORDS 3456
#define XB_SPIN_CAP (1u << 18)
__device__ __forceinline__ unsigned xb_ld(unsigned* p)              { return __hip_atomic_load(p, __ATOMIC_RELAXED, __HIP_MEMORY_SCOPE_AGENT); }
__device__ __forceinline__ unsigned xb_add(unsigned* p, unsigned v) { return __hip_atomic_fetch_add(p, v, __ATOMIC_RELAXED, __HIP_MEMORY_SCOPE_AGENT); }
__device__ __forceinline__ unsigned xb_xcc_id() { return (unsigned)__builtin_amdgcn_s_getreg((3 << 11) | 20) & 0xFu; }
#define XB_SPIN(cond, bar) do { unsigned _sp = 0; while (cond) { __builtin_amdgcn_s_sleep(1); \
    if ((++_sp & 255u) == 0u) { if (xb_ld(&(bar)[XB_TMO])) break; if (_sp > XB_SPIN_CAP) { atomicAdd(&(bar)[XB_TMO], 1u); break; } } } } while (0)
struct XcdBarrier { unsigned* bar; unsigned x; volatile LAS unsigned* st; };
__device__ __forceinline__ void xcd_barrier_complete(unsigned* bar, unsigned x, unsigned& nloc, unsigned& nx) {
    const unsigned G = gridDim.x * gridDim.y * gridDim.z;
    unsigned sum, cnt, mine, sp = 0u;
    for (;;) {
        sum = 0u; cnt = 0u; mine = 0u;
#pragma unroll
        for (unsigned j = 0; j < 16; ++j) { const unsigned c = xb_ld(&bar[XB_XCNT(j)]); sum += c; cnt += (c > 0u) ? 1u : 0u; mine = (j == x) ? c : mine; }
        if (sum == G) break;
        __builtin_amdgcn_s_sleep(1);
        if ((++sp & 255u) == 0u) { if (xb_ld(&bar[XB_TMO])) break; if (sp > XB_SPIN_CAP) { atomicAdd(&bar[XB_TMO], 1u); break; } }
    }
    nloc = mine > 0u ? mine : 1u; nx = cnt > 0u ? cnt : 1u;
}
__device__ __forceinline__ void xcd_barrier_impl(const XcdBarrier& b, bool leader) {
    asm volatile("s_waitcnt vmcnt(0)" ::: "memory");
    __syncthreads();
    if (leader) {
        unsigned* bar = b.bar;
        __builtin_amdgcn_s_waitcnt(0);
        unsigned nloc = b.st[0], nx = b.st[1];
        if (nloc == 0u) { xcd_barrier_complete(bar, b.x, nloc, nx); b.st[0] = nloc; b.st[1] = nx; }
        const unsigned old = xb_add(&bar[XB_XSUB(b.x)], 1u);
        const unsigned gen = old / nloc;
        if (old + 1u == (gen + 1u) * nloc) {
            __builtin_amdgcn_fence(__ATOMIC_RELEASE, "agent");
            asm volatile("s_waitcnt vmcnt(0)" ::: "memory");
            const unsigned og = xb_add(&bar[XB_TOP], 1u);
            const unsigned tg = og / nx;
            if (og + 1u == (tg + 1u) * nx) xb_add(&bar[XB_TOPGEN], 1u);
            else XB_SPIN(xb_ld(&bar[XB_TOPGEN]) == tg, bar);
            __builtin_amdgcn_fence(__ATOMIC_ACQUIRE, "agent");
            xb_add(&bar[XB_XGEN(b.x)], 1u);
            asm volatile("s_waitcnt vmcnt(0)" ::: "memory");
        } else {
            XB_SPIN(xb_ld(&bar[XB_XGEN(b.x)]) == gen, bar);
            __builtin_amdgcn_fence(__ATOMIC_ACQUIRE, "agent");
            asm volatile("s_waitcnt vmcnt(0)" ::: "memory");
        }
    }
    __syncthreads();
}

struct Args { const float* in[14]; float* out; unsigned char* ws; };
template <int SLOT> __device__ __forceinline__ unsigned long long karg_u64() {
#if defined(__HIP_DEVICE_COMPILE__)
    auto ka = __builtin_amdgcn_kernarg_segment_ptr(); unsigned long long v;
    asm volatile("s_load_dwordx2 %0, %1, %2\n\ts_waitcnt lgkmcnt(0)" : "=s"(v) : "s"(ka), "i"(SLOT * 8) : "memory");
    return v;
#else
    return 0ull;
#endif
}
template <int I> __device__ __forceinline__ const float* karg_in() { return (const float*)(const GAS float*)karg_u64<I>(); }
__device__ __forceinline__ float* karg_out() { return (float*)(GAS float*)karg_u64<14>(); }
__device__ __forceinline__ unsigned char* karg_ws() { return (unsigned char*)(GAS unsigned char*)karg_u64<15>(); }
struct Frame {
    LAS unsigned char* lds; int tid, lane, wave, vcu, G;
};


__device__ __forceinline__ float wave_sum(float v) {
#pragma unroll
    for (int o = 1; o < 64; o <<= 1) v += __shfl_xor(v, o);
    return v;
}

__device__ __forceinline__ void pool_item(const float* Wo, const float* P, const float* sc, bf16_t* WT, int k0, int n0, LAS float* scr, int lane) {
    const int c4 = lane & 7, g = (k0 - 512) >> 7, cb = ((k0 - 512) & 127) + (lane >> 3);
    const float* s = sc + 128 * g; const float* w = Wo + (size_t)(512 + 128 * g) * D + n0 + 4 * c4; const float* pp = P + ((size_t)g * 128 + cb) * 128;
    f32x4 acc[8];
#pragma unroll
    for (int i = 0; i < 8; ++i) acc[i] = (f32x4){0.f, 0.f, 0.f, 0.f};
#pragma unroll 2
    for (int d = 0; d < 128; d += 4) {
        const f32x4 s4 = *(const f32x4*)(s + d);
        f32x4 wv[4], p4[8];
#pragma unroll
        for (int j = 0; j < 4; ++j) wv[j] = *(const f32x4*)(w + (size_t)(d + j) * D);
#pragma unroll
        for (int i = 0; i < 8; ++i) p4[i] = *(const f32x4*)(pp + (size_t)(8 * i) * 128 + d);
#pragma unroll
        for (int i = 0; i < 8; ++i)
#pragma unroll
            for (int j = 0; j < 4; ++j) { const float ps = p4[i][j] * s4[j]; acc[i][0] = fmaf(ps, wv[j][0], acc[i][0]); acc[i][1] = fmaf(ps, wv[j][1], acc[i][1]); acc[i][2] = fmaf(ps, wv[j][2], acc[i][2]); acc[i][3] = fmaf(ps, wv[j][3], acc[i][3]); }
    }
#pragma unroll
    for (int i = 0; i < 8; ++i) { const int kk = 8 * i + (lane >> 3); LAS float* dd = scr + kk * 33 + 4 * c4; dd[0] = acc[i][0]; dd[1] = acc[i][1]; dd[2] = acc[i][2]; dd[3] = acc[i][3]; }
    LDS_WAIT(); asm volatile("" ::: "memory");
    const int c = lane & 7;
#pragma unroll
    for (int j = 0; j < 4; ++j) { const int n = (lane >> 3) + 8 * j; const LAS float* sp = scr + (8 * c) * 33 + n;
        u32x4 o; o.x = pk2(sp[0 * 33], sp[1 * 33]); o.y = pk2(sp[2 * 33], sp[3 * 33]); o.z = pk2(sp[4 * 33], sp[5 * 33]); o.w = pk2(sp[6 * 33], sp[7 * 33]);
        *(GAS u32x4*)(WT + (size_t)(n0 + n) * D + k0 + 8 * c) = o; }
    LDS_WAIT(); asm volatile("" ::: "memory");
}
template <class F> __device__ __forceinline__ void tr_item(const F& f, bf16_t* WT, int Kd, int k0, int n0, LAS float* scr, int lane) {
    const int c4 = lane & 7;
#pragma unroll
    for (int i = 0; i < 8; ++i) { const int kk = 8 * i + (lane >> 3); const f32x4 v = f(k0 + kk, n0 + 4 * c4); LAS float* d = scr + kk * 33 + 4 * c4; d[0] = v[0]; d[1] = v[1]; d[2] = v[2]; d[3] = v[3]; }
    LDS_WAIT(); asm volatile("" ::: "memory");
    const int c = lane & 7;
#pragma unroll
    for (int j = 0; j < 4; ++j) { const int n = (lane >> 3) + 8 * j; const LAS float* s = scr + (8 * c) * 33 + n;
        u32x4 o; o.x = pk2(s[0 * 33], s[1 * 33]); o.y = pk2(s[2 * 33], s[3 * 33]); o.z = pk2(s[4 * 33], s[5 * 33]); o.w = pk2(s[6 * 33], s[7 * 33]);
        *(GAS u32x4*)(WT + (size_t)(n0 + n) * Kd + k0 + 8 * c) = o; }
    LDS_WAIT(); asm volatile("" ::: "memory");
}
__device__ __forceinline__ int ein_src(int np) {
    const int pn = np >> 8, cl = np & 255, bj = cl >> 7, wc = (cl >> 5) & 3, i = cl & 31;
    const int L = 256 * pn + 64 * wc + 32 * bj + i;
    if (L < 1024) return L;
    if (L < 1536) return 1092 + (L - 1024);
    if (L < 1600) return 1024 + (L - 1536);
    if (L < 1604) return 1088 + (L - 1600);
    return -1;
}
struct FEin { const float* W; const float* g; __device__ __forceinline__ f32x4 operator()(int k, int np) const { const int s = ein_src(np); if (s < 0) return (f32x4){0.f, 0.f, 0.f, 0.f}; return *(const f32x4*)(W + (size_t)k * EIN_SRC + s) * g[k]; } };
struct FPlain { const float* W; int N; const float* g; __device__ __forceinline__ f32x4 operator()(int k, int np) const { const f32x4 v = *(const f32x4*)(W + (size_t)k * N + np); return g ? v * g[k] : v; } };
struct FUp { const float* W; const float* g; __device__ __forceinline__ f32x4 operator()(int k, int np) const {
    const int pn = np >> 8, j = np & 127; return *(const f32x4*)(W + (size_t)k * FF + 128 * pn + j) * g[k]; } };
struct FPool { const float* Wo; const float* P; const float* sc; __device__ __forceinline__ f32x4 operator()(int k, int n) const {
    const int g = (k - 512) >> 7, c = (k - 512) & 127; const float* p = P + ((size_t)g * 128 + c) * 128; const float* s = sc + 128 * g; const float* w = Wo + (size_t)(512 + 128 * g) * D + n;
    f32x4 a = {0.f, 0.f, 0.f, 0.f};
#pragma unroll 8
    for (int d = 0; d < 128; ++d) { const float ps = p[d] * s[d]; const f32x4 wv = *(const f32x4*)(w + (size_t)d * D); a[0] = fmaf(ps, wv[0], a[0]); a[1] = fmaf(ps, wv[1], a[1]); a[2] = fmaf(ps, wv[2], a[2]); a[3] = fmaf(ps, wv[3], a[3]); }
    return a; } };

struct TrDesc { const float* W; const float* g; bf16_t* dst; int srcN, Kd, k0, n0, kind; };
__device__ __forceinline__ void tr_decode(int r, TrDesc& d, unsigned char* ws) {
    constexpr int I_EOUT = (512 / 64) * (D / 32), I_EIN = (D / 64) * (EIN / 32), I_OQKV = (D / 64) * (3 * D / 32), I_OOUT = (D / 64) * (D / 32), I_UP = (D / 64) * (2 * FF / 32), I_DN = (FF / 64) * (D / 32);
    d.g = nullptr; d.kind = 0; d.Kd = D;
    if (r < 2 * I_EOUT) { const int l = r / I_EOUT; r %= I_EOUT; const int nblk = D / 32; d.k0 = 64 * (r / nblk); d.n0 = 32 * (r % nblk);
        d.W = karg_in<4>() + (size_t)l * D * D; d.srcN = D; d.dst = (bf16_t*)(ws + WS_W_EOUT + l * SZ_SQ); return; } r -= 2 * I_EOUT;
    if (r < 2 * I_EIN) { const int l = r / I_EIN; r %= I_EIN; const int nblk = EIN / 32; d.k0 = 64 * (r / nblk); d.n0 = 32 * (r % nblk);
        d.W = karg_in<3>() + (size_t)l * D * EIN_SRC; d.srcN = EIN_SRC; d.g = karg_in<1>() + (size_t)(2 * l) * D; d.kind = 1; d.dst = (bf16_t*)(ws + WS_W_EIN + l * SZ_EIN); return; } r -= 2 * I_EIN;
    if (r < 2 * I_OOUT) { const int l = r / I_OOUT; r %= I_OOUT; const int nblk = D / 32; d.k0 = 64 * (r / nblk); d.n0 = 32 * (r % nblk);
        d.W = karg_in<10>() + (size_t)l * D * D; d.srcN = D; d.dst = (bf16_t*)(ws + WS_W_OOUT + l * SZ_SQ); return; } r -= 2 * I_OOUT;
    { const int l = r / I_DN; r %= I_DN; const int nblk = D / 32; d.k0 = 64 * (r / nblk); d.n0 = 32 * (r % nblk);
        d.W = karg_in<13>() + (size_t)l * FF * D; d.srcN = D; d.Kd = FF; d.dst = (bf16_t*)(ws + WS_W_DN + l * SZ_DN); }
}
__device__ __forceinline__ void tr_load(const TrDesc& d, f32x4 (&v)[8], float (&gv)[8], int lane) {
    const int np = d.n0 + 4 * (lane & 7);
    const int col = d.kind == 0 ? np : (d.kind == 1 ? ein_src(np) : 128 * (np >> 8) + (np & 127));
    const int colc = col >= 0 ? col : 0;
    const float* gp = d.g ? d.g : d.W;
#pragma unroll
    for (int i = 0; i < 8; ++i) { const int k = d.k0 + 8 * i + (lane >> 3); v[i] = *(const f32x4*)(d.W + (size_t)k * d.srcN + colc); gv[i] = gp[k]; }
}
__device__ __forceinline__ void tr_store(const TrDesc& d, const f32x4 (&v)[8], const float (&gv)[8], LAS float* scr, int lane) {
    const int c4 = lane & 7;
    const int np = d.n0 + 4 * c4; const bool pad = d.kind == 1 && ein_src(np) < 0; const bool hasg = d.g != nullptr;
#pragma unroll
    for (int i = 0; i < 8; ++i) { const int kk = 8 * i + (lane >> 3); LAS float* p = scr + kk * 33 + 4 * c4; const float gm = pad ? 0.f : (hasg ? gv[i] : 1.f);
        p[0] = v[i][0] * gm; p[1] = v[i][1] * gm; p[2] = v[i][2] * gm; p[3] = v[i][3] * gm; }
    LDS_WAIT(); asm volatile("" ::: "memory");
    const int c = lane & 7;
#pragma unroll
    for (int j = 0; j < 4; ++j) { const int n = (lane >> 3) + 8 * j; const LAS float* s = scr + (8 * c) * 33 + n;
        u32x4 o; o.x = pk2(s[0 * 33], s[1 * 33]); o.y = pk2(s[2 * 33], s[3 * 33]); o.z = pk2(s[4 * 33], s[5 * 33]); o.w = pk2(s[6 * 33], s[7 * 33]);
        *(GAS u32x4*)(d.dst + (size_t)(d.n0 + n) * d.Kd + d.k0 + 8 * c) = o; }
    LDS_WAIT(); asm volatile("" ::: "memory");
}
constexpr int N_STRIPS = 2 * FF / 32;
__device__ __forceinline__ void q8_strip(const float* W, int pitch, const float* g, signed char* dst, float* sw, int n0, LAS float* scr, int lane, float swm = 1.0f  ) {
    const int kr = lane >> 3;
    f32x4 mx = {0.f, 0.f, 0.f, 0.f};
#pragma unroll 2
    for (int kb = 0; kb < D / 64; ++kb) {
#pragma unroll
        for (int i = 0; i < 8; ++i) { const int k = 64 * kb + 8 * i + kr; const f32x4 v = *(const f32x4*)(W + (size_t)k * pitch) * g[k];
            mx[0] = __builtin_fmaxf(mx[0], __builtin_fabsf(v[0])); mx[1] = __builtin_fmaxf(mx[1], __builtin_fabsf(v[1])); mx[2] = __builtin_fmaxf(mx[2], __builtin_fabsf(v[2])); mx[3] = __builtin_fmaxf(mx[3], __builtin_fabsf(v[3])); } }
#pragma unroll
    for (int c = 0; c < 4; ++c) { float m = mx[c]; m = __builtin_fmaxf(m, shfl_xor_f(m, 8, lane)); m = __builtin_fmaxf(m, shfl_xor_f(m, 16, lane)); m = __builtin_fmaxf(m, shfl_xor_f(m, 32, lane)); mx[c] = m; }
    f32x4 inv, step;
#pragma unroll
    for (int c = 0; c < 4; ++c) { step[c] = mx[c] > 0.f ? mx[c] * (1.0f / 127.0f) : 1.0f; inv[c] = mx[c] > 0.f ? 127.0f / mx[c] : 0.f; }
    if (lane < 8) *(f32x4*)(sw + n0 + 4 * lane) = step * swm;
    for (int kb = 0; kb < D / 64; ++kb) {
#pragma unroll
        for (int i = 0; i < 8; ++i) { const int kk = 8 * i + kr; const int k = 64 * kb + kk; const f32x4 v = *(const f32x4*)(W + (size_t)k * pitch) * g[k];
            LAS float* p = scr + kk * 33 + 4 * (lane & 7); p[0] = __builtin_rintf(v[0] * inv[0]); p[1] = __builtin_rintf(v[1] * inv[1]); p[2] = __builtin_rintf(v[2] * inv[2]); p[3] = __builtin_rintf(v[3] * inv[3]); }
        LDS_WAIT(); asm volatile("" ::: "memory");
        const int c = lane & 7;
#pragma unroll
        for (int j = 0; j < 4; ++j) { const int n = (lane >> 3) + 8 * j; const LAS float* sp = scr + (8 * c) * 33 + n;
            u32x2 o;
            o.x = ((unsigned)(int)sp[0 * 33] & 0xFFu) | (((unsigned)(int)sp[1 * 33] & 0xFFu) << 8) | (((unsigned)(int)sp[2 * 33] & 0xFFu) << 16) | (((unsigned)(int)sp[3 * 33] & 0xFFu) << 24);
            o.y = ((unsigned)(int)sp[4 * 33] & 0xFFu) | (((unsigned)(int)sp[5 * 33] & 0xFFu) << 8) | (((unsigned)(int)sp[6 * 33] & 0xFFu) << 16) | (((unsigned)(int)sp[7 * 33] & 0xFFu) << 24);
            *(GAS u32x2*)(dst + (size_t)(n0 + n) * D + 64 * kb + 8 * c) = o; }
        LDS_WAIT(); asm volatile("" ::: "memory");
    }
}
__device__ __forceinline__ void up_strip(int layer, int strip, unsigned char* ws, LAS float* scr, int lane) {
    const int n0 = 32 * strip; const float* w1p = karg_in<11>(); const float* w3p = karg_in<12>();
    const float* W = (((n0 >> 7) & 1) ? w3p : w1p) + (size_t)layer * D * FF + 128 * (n0 >> 8) + (n0 & 127) + 4 * (lane & 7);
    q8_strip(W, FF, karg_in<2>() + (size_t)layer * D, (signed char*)(ws + WS_W_UP + layer * SZ_UP), (float*)(ws + WS_SW) + (size_t)layer * 2 * FF, n0, scr, lane, ((n0 >> 7) & 1) ? 0.6931471805599453f : 1.4426950408889634f);
}
constexpr int Q_STRIPS = 3 * D / 32;
__device__ __forceinline__ void qkv_strip(int l, int strip, unsigned char* ws, LAS float* scr, int lane) {
    const int n0 = 32 * strip;
    q8_strip(karg_in<9>() + (size_t)l * D * 3 * D + n0 + 4 * (lane & 7), 3 * D, karg_in<1>() + (size_t)(2 * l + 1) * D, (signed char*)(ws + WS_W_OQKV + l * SZ_OQKV), (float*)(ws + WS_SWQ) + (size_t)l * 3 * D, n0, scr, lane);
}
__device__ __forceinline__ void quant_rows(unsigned char* ws, size_t xq_off, size_t sar_off, int gw, int NGW, int lane) {
    const bf16_t* xb = (const bf16_t*)(ws + WS_XB); signed char* xq = (signed char*)(ws + xq_off); float* sar = (float*)(ws + sar_off); const float* ssp = (const float*)(ws + WS_SSP);
    for (int m = gw; m < M; m += 8 * NGW) {
        u32x4 a[8][2]; float mx[8];
#pragma unroll
        for (int q = 0; q < 8; ++q) { const u32x4* p = (const u32x4*)(xb + (size_t)(m + q * NGW) * D + 16 * lane); a[q][0] = p[0]; a[q][1] = p[1]; }
        float ssv = 0.f;
        if (lane < 32) { const f32x4 s4 = *(const f32x4*)(ssp + (size_t)(m + (lane >> 2) * NGW) * 16 + 4 * (lane & 3)); ssv = (s4[0] + s4[1]) + (s4[2] + s4[3]); }
        ssv += shfl_xor_f(ssv, 1, lane); ssv += shfl_xor_f(ssv, 2, lane);
#pragma unroll
        for (int q = 0; q < 8; ++q) { float t = 0.f;
#pragma unroll
            for (int i = 0; i < 8; ++i) { const unsigned wd = a[q][i >> 2][i & 3]; t = __builtin_fmaxf(t, __builtin_fmaxf(__builtin_fabsf(__uint_as_float(wd << 16)), __builtin_fabsf(__uint_as_float(wd & 0xFFFF0000u)))); }
            mx[q] = t; }
#pragma unroll
        for (int o = 1; o < 64; o <<= 1) {
#pragma unroll
            for (int q = 0; q < 8; ++q) mx[q] = __builtin_fmaxf(mx[q], shfl_xor_f(mx[q], o, lane)); }
        float mysar = 0.f;
#pragma unroll
        for (int q = 0; q < 8; ++q) { const int row = m + q * NGW;
            const float inv = mx[q] > 0.f ? 127.0f / mx[q] : 0.f, step = mx[q] > 0.f ? mx[q] * (1.0f / 127.0f) : 1.0f;
            if (lane == 4 * q) mysar = rsqrtf(ssv * (1.0f / D) + EPS) * step;
            u32x4 o4;
#pragma unroll
            for (int w4 = 0; w4 < 4; ++w4) { const unsigned w0 = a[q][w4 >> 1][2 * (w4 & 1)], w1 = a[q][w4 >> 1][2 * (w4 & 1) + 1];
                const int q0 = (int)__builtin_rintf(__uint_as_float(w0 << 16) * inv), q1 = (int)__builtin_rintf(__uint_as_float(w0 & 0xFFFF0000u) * inv);
                const int q2 = (int)__builtin_rintf(__uint_as_float(w1 << 16) * inv), q3 = (int)__builtin_rintf(__uint_as_float(w1 & 0xFFFF0000u) * inv);
                o4[w4] = ((unsigned)q0 & 0xFFu) | (((unsigned)q1 & 0xFFu) << 8) | (((unsigned)q2 & 0xFFu) << 16) | (((unsigned)q3 & 0xFFu) << 24); }
            st16_wt(xq + (size_t)row * D + 16 * lane, o4);
        }
        if (lane < 32 && (lane & 3) == 0) sar[m + (lane >> 2) * NGW] = mysar;
    }
}
__device__ __forceinline__ void p0_prologue(const Frame& F) {
    LAS float* scr = (LAS float*)(F.lds + F.wave * 16384);
    const int gw = F.vcu * 8 + F.wave, NGW = F.G * 8;
    unsigned char* ws = karg_ws();
    constexpr int I_POOL = (512 / 64) * (D / 32);
    constexpr int I_EOUT = (512 / 64) * (D / 32), I_EIN = (D / 64) * (EIN / 32), I_OQKV = (D / 64) * (3 * D / 32), I_OOUT = (D / 64) * (D / 32), I_UP = (D / 64) * (2 * FF / 32), I_DN = (FF / 64) * (D / 32);
    constexpr int NITEMS = 2 * (I_EOUT + I_EIN + I_OOUT) + 4 * I_DN;
    const int role = gw & 3, ridx = gw >> 2;
    constexpr int NSTR = 4 * N_STRIPS + 2 * Q_STRIPS;
    if (role == 0 && ridx < 2 * I_POOL) { const int it = ridx; const int l = it / I_POOL, r = it % I_POOL; const int nblk = D / 32, kb = r / nblk, nb = r % nblk;
        pool_item(karg_in<4>() + (size_t)l * D * D, karg_in<7>() + (size_t)l * 4 * 128 * 128, karg_in<8>() + (size_t)l * 512, (bf16_t*)(ws + WS_W_EOUT + l * SZ_SQ), 512 + 64 * kb, 32 * nb, scr, F.lane); }
    else if (role == 1 || (role == 2 && ridx < NSTR - 512)) { const int sidx = role == 1 ? ridx : 512 + ridx;
        if (sidx < 4 * N_STRIPS) up_strip(sidx / N_STRIPS, sidx % N_STRIPS, ws, scr, F.lane); else { const int q = sidx - 4 * N_STRIPS; qkv_strip(q / Q_STRIPS, q % Q_STRIPS, ws, scr, F.lane); } }
    else if (role >= 2) {
      const int NPL = 512 + (512 - (NSTR - 512));
      int it = role == 3 ? ridx : 512 + ridx - (NSTR - 512);
      TrDesc dA, dB; f32x4 vA[8], vB[8]; float gA[8], gB[8];
      if (it < NITEMS) { tr_decode(it, dA, ws); tr_load(dA, vA, gA, F.lane); }
      while (it < NITEMS) {
          const int itB = it + NPL;
          if (itB < NITEMS) { tr_decode(itB, dB, ws); tr_load(dB, vB, gB, F.lane); }
          tr_store(dA, vA, gA, scr, F.lane);
          if (itB >= NITEMS) break;
          const int itA = itB + NPL;
          if (itA < NITEMS) { tr_decode(itA, dA, ws); tr_load(dA, vA, gA, F.lane); }
          tr_store(dB, vB, gB, scr, F.lane);
          it = itA;
      } }
    const float* x = karg_in<0>();
    bf16_t* xb = (bf16_t*)(ws + WS_XB); float* ssp = (float*)(ws + WS_SSP);
    const bool is_strip = (role == 1) || (role == 2 && ridx < NSTR - 512);
    if (!is_strip) {
        const int NRW = NGW - NSTR;
        const int rw = role == 0 ? ridx : (role == 3 ? 512 + ridx : 1024 + ridx - (NSTR - 512));
        for (int m = rw; m < M; m += 2 * NRW) {
            const int m2 = m + NRW; const bool two = m2 < M;
            const GAS f32x4* xr = (const GAS f32x4*)(x + (size_t)m * D) + F.lane; const GAS f32x4* xr2 = (const GAS f32x4*)(x + (size_t)(two ? m2 : m) * D) + F.lane; f32x4 v[4], v2[4]; float s = 0.f, s2 = 0.f;
#pragma unroll
            for (int j = 0; j < 4; ++j) { v[j] = xr[64 * j]; v2[j] = xr2[64 * j]; }
#pragma unroll
            for (int j = 0; j < 4; ++j) { s += (v[j][0] * v[j][0] + v[j][1] * v[j][1]) + (v[j][2] * v[j][2] + v[j][3] * v[j][3]); s2 += (v2[j][0] * v2[j][0] + v2[j][1] * v2[j][1]) + (v2[j][2] * v2[j][2] + v2[j][3] * v2[j][3]); }
            s = wave_sum(s); s2 = wave_sum(s2);
            GAS unsigned long long* o8 = (GAS unsigned long long*)(xb + (size_t)m * D) + F.lane;
#pragma unroll
            for (int j = 0; j < 4; ++j) o8[64 * j] = (unsigned long long)pk2(v[j][0], v[j][1]) | ((unsigned long long)pk2(v[j][2], v[j][3]) << 32);
            if (F.lane < 16) ssp[(size_t)m * 16 + F.lane] = (F.lane == 0) ? s : 0.f;
            if (two) { GAS unsigned long long* o82 = (GAS unsigned long long*)(xb + (size_t)m2 * D) + F.lane;
#pragma unroll
                for (int j = 0; j < 4; ++j) o82[64 * j] = (unsigned long long)pk2(v2[j][0], v2[j][1]) | ((unsigned long long)pk2(v2[j][2], v2[j][3]) << 32);
                if (F.lane < 16) ssp[(size_t)m2 * 16 + F.lane] = (F.lane == 0) ? s2 : 0.f; }
        }
    }
}

__device__ __forceinline__ int crow(int r, int hi) { return (r & 3) + 8 * (r >> 2) + 4 * hi; }
typedef short v4i16_t __attribute__((ext_vector_type(4)));
__device__ __forceinline__ s16x4 vtr(const LAS char* p) { return __builtin_bit_cast(s16x4, __builtin_amdgcn_ds_read_tr16_b64_v4i16((LAS v4i16_t*)p)); }
typedef __bf16 bf16x2_t __attribute__((ext_vector_type(2)));
__device__ __forceinline__ unsigned cvtpk(float lo, float hi) { f32x2 v = {lo, hi}; bf16x2_t b = __builtin_convertvector(v, bf16x2_t); return __builtin_bit_cast(unsigned, b); }
__device__ __forceinline__ float swap_other(float v, int hi) {
    auto rr = __builtin_amdgcn_permlane32_swap(__float_as_uint(v), __float_as_uint(v), false, false);
    return __uint_as_float(hi ? rr[0] : rr[1]);
}
__device__ __forceinline__ unsigned swap_or(unsigned v) { auto rr = __builtin_amdgcn_permlane32_swap(v, v, false, false); return rr[0] | rr[1]; }

__device__ __forceinline__ void load_kfrag(bf16x8 (&kf)[8], const bf16_t* Kt  , int pitch, int r32, int hi) {
    const unsigned koff = (unsigned)(r32 * pitch + 8 * hi) * 2u;
#pragma unroll
    for (int d0 = 0; d0 < 4; ++d0)
#pragma unroll
        for (int h = 0; h < 2; ++h) kf[2 * d0 + h] = *(const bf16x8*)((const char*)Kt + (size_t)(32 * h * pitch + 16 * d0) * 2 + koff);
}
__device__ __forceinline__ void qkt(f32x16& p0, f32x16& p1, const bf16x8 (&kf)[8], const bf16x8 (&qr)[4]) {
    p0 = f32x16{}; p1 = f32x16{};
#pragma unroll
    for (int d0 = 0; d0 < 4; ++d0) {
        p0 = __builtin_amdgcn_mfma_f32_32x32x16_bf16(kf[2 * d0], qr[d0], p0, 0, 0, 0);
        p1 = __builtin_amdgcn_mfma_f32_32x32x16_bf16(kf[2 * d0 + 1], qr[d0], p1, 0, 0, 0);
    }
}
__device__ __forceinline__ void load_vtile(u32x4 (&vr)[8], const bf16_t* Vt  , int pitch, int lane) {
    const unsigned voff = (unsigned)((lane >> 2) * pitch + (lane & 3) * 8) * 2u;
#pragma unroll
    for (int p = 0; p < 8; ++p) vr[p] = *(const u32x4*)((const char*)Vt + (size_t)(16 * (p & 3) * pitch + (p >> 2) * 32) * 2 + voff);
}
__device__ __forceinline__ void glds16_s(const void* sbase  , unsigned voff  , unsigned lds_dst  ) {
    unsigned keep;
    asm volatile("s_nop 4\n\ts_mov_b32 %0, m0\n\ts_mov_b32 m0, %3\n\ts_nop 0\n\tglobal_load_lds_dwordx4 %1, %2\n\ts_mov_b32 m0, %0" : "=&s"(keep) : "v"(voff), "s"(sbase), "s"(lds_dst) : "memory");
}
__device__ __forceinline__ void dma_vtile(const bf16_t* Vt  , int pitch, int lane, LAS char* vslot  ) {
    const unsigned voff = (unsigned)((lane >> 2) * pitch + (lane & 3) * 8) * 2u;
    const unsigned l0 = (unsigned)(size_t)vslot;
#pragma unroll
    for (int p = 0; p < 8; ++p) glds16_s((const char*)Vt + (size_t)(16 * (p & 3) * pitch + (p >> 2) * 32) * 2, voff, l0 + p * 1024);
}
__device__ __forceinline__ void store_vtile(const u32x4 (&vr)[8], LAS char* vslot, int lane) {
#pragma unroll
    for (int p = 0; p < 8; ++p) *(LAS u32x4*)(vslot + p * 1024 + lane * 16) = vr[p];
}
__device__ __forceinline__ void pv_load(bf16x8 (&vf)[8], const LAS char* vp0) {
#pragma unroll
    for (int ks = 0; ks < 4; ++ks)
#pragma unroll
        for (int d0 = 0; d0 < 2; ++d0) {
            const s16x4 lo = vtr(vp0 + d0 * 4096 + ks * 1024), hi4 = vtr(vp0 + d0 * 4096 + ks * 1024 + 512);
            vf[2 * ks + d0] = (bf16x8){lo[0], lo[1], lo[2], lo[3], hi4[0], hi4[1], hi4[2], hi4[3]};
        }
}
__device__ __forceinline__ void pv_mma(f32x16 (&o)[2], const bf16x8 (&vf)[8], const f32x16& P0, const f32x16& P1) {
    u32x4 pw[4];
#pragma unroll
    for (int i = 0; i < 4; ++i) { pw[0][i] = cvtpk(P0[2 * i], P0[2 * i + 1]); pw[1][i] = cvtpk(P0[8 + 2 * i], P0[9 + 2 * i]); pw[2][i] = cvtpk(P1[2 * i], P1[2 * i + 1]); pw[3][i] = cvtpk(P1[8 + 2 * i], P1[9 + 2 * i]); }
#pragma unroll
    for (int ks = 0; ks < 4; ++ks)
#pragma unroll
        for (int d0 = 0; d0 < 2; ++d0) o[d0] = __builtin_amdgcn_mfma_f32_32x32x16_bf16(__builtin_bit_cast(bf16x8, pw[ks]), vf[2 * ks + d0], o[d0], 0, 0, 0);
}
__device__ __forceinline__ void pv(f32x16 (&o)[2], const LAS char* vp0, const f32x16& P0, const f32x16& P1) {
    bf16x8 vf[8]; pv_load(vf, vp0); __builtin_amdgcn_sched_barrier(0); pv_mma(o, vf, P0, P1);
}
__device__ __forceinline__ void store_o(const f32x16 (&o)[2], const float (&rsc)[16], LAS char* stgc, bf16_t* Ow  , int pitch, int lane, int r32, int hi) {
    LAS bf16_t* stg = (LAS bf16_t*)stgc;
#pragma unroll
    for (int r = 0; r < 16; ++r) { const int orow = crow(r, hi);
#pragma unroll
        for (int d0 = 0; d0 < 2; ++d0) stg[orow * 64 + d0 * 32 + r32] = (bf16_t)f2bf(o[d0][r] * rsc[r]); }
    LDS_WAIT();
#pragma unroll
    for (int i = 0; i < 4; ++i) { const int row = i * 8 + (lane >> 3), ch = lane & 7; const u32x4 v = *(const LAS u32x4*)(stg + row * 64 + ch * 8); st16_wt(Ow + (size_t)row * pitch + ch * 8, v); }
    LDS_WAIT();
}

constexpr int WL_V = 0, WL_O = 0, WL_F = 16384, WL_STRIDE = 16640;
static_assert(8 * WL_STRIDE <= LDSCTL_OFF, "per-wave attention scratch");

template <bool diag> __device__ __forceinline__ void sb_tile_math_t(f32x16& z0, f32x16& z1, float& carry, int s0, int tq, int hi) {
        f32x16 q0, q1;
#pragma unroll
        for (int r = 0; r < 16; ++r) {
            const int kv = s0 + crow(r, hi);
            { float q = __builtin_amdgcn_rcpf(1.0f + __builtin_amdgcn_exp2f(z0[r])); if (diag && !(kv < tq)) q = 1.f; q0[r] = q; }
            { float q = __builtin_amdgcn_rcpf(1.0f + __builtin_amdgcn_exp2f(z1[r])); if (diag && !(kv + 32 < tq)) q = 1.f; q1[r] = q; }
        }
        float own[8], oth[8], S[8];
#pragma unroll
        for (int G = 0; G < 4; ++G) { own[G] = (q0[4 * G] * q0[4 * G + 1]) * (q0[4 * G + 2] * q0[4 * G + 3]); own[4 + G] = (q1[4 * G] * q1[4 * G + 1]) * (q1[4 * G + 2] * q1[4 * G + 3]); }
#pragma unroll
        for (int i = 0; i < 8; ++i) { const auto rr = __builtin_amdgcn_permlane32_swap(__float_as_uint(own[i]), __float_as_uint(own[i]), false, false);
            own[i] = __uint_as_float(rr[0]) * __uint_as_float(rr[1]); oth[i] = __uint_as_float(rr[1]); }
        float run = 1.f;
#pragma unroll
        for (int i = 7; i >= 0; --i) { S[i] = run; run *= own[i]; }
#pragma unroll
        for (int i = 0; i < 8; ++i) {
            float after = carry * S[i] * (hi == 0 ? oth[i] : 1.f);
#pragma unroll
            for (int e = 3; e >= 0; --e) {
                const int r = 4 * (i & 3) + e;
                if (i < 4) { const float q = q0[r]; z0[r] = (1.0f - q) * after; after *= q; }
                else       { const float q = q1[r]; z1[r] = (1.0f - q) * after; after *= q; }
            }
        }
        carry *= run;
}
__device__ __forceinline__ void sb_tile_math(f32x16& z0, f32x16& z1, float& carry, bool diag, int s0, int tq, int hi) {
    if (diag) sb_tile_math_t<true>(z0, z1, carry, s0, tq, hi); else sb_tile_math_t<false>(z0, z1, carry, s0, tq, hi);
}

__device__ __forceinline__ void sb_unit(int b, int h, int qb, const bf16_t* Q, const bf16_t* K, const bf16_t* V, bf16_t* O, LAS char* wl, int lane, bool dry) {
    const int r32 = lane & 31, hi = lane >> 5; const int t0 = qb * 32; const size_t rowbase = (size_t)b * T;
    const bf16_t* Qw = Q + (rowbase + t0) * D + h * 64; const bf16_t* Kh = K + rowbase * D + h * 64; const bf16_t* Vh = V + rowbase * D + h * 64;
    bf16x8 qr[4];
#pragma unroll
    for (int d0 = 0; d0 < 4; ++d0) qr[d0] = *(const bf16x8*)(Qw + (size_t)r32 * D + 16 * d0 + 8 * hi);
    f32x16 o[2]; o[0] = f32x16{}; o[1] = f32x16{};
    float carry = 1.f; const int tq = t0 + r32; const int jd = t0 >> 6;
    const LAS char* vp0 = wl + WL_V + ((lane >> 4) & 1) * 32 + (lane & 3) * 8 + (4 * hi + ((lane & 15) >> 2)) * 64;
    bf16x8 kf[8];
    load_kfrag(kf, Kh + (size_t)jd * 64 * D, D, r32, hi);
    dma_vtile(Vh + (size_t)jd * 64 * D, D, lane, wl + WL_V);
    int slot = 0;
    for (int j = jd; j >= 0; --j) {
        const int s0 = j * 64;
        VM_WAIT();
        if (j > 0) dma_vtile(Vh + (size_t)(s0 - 64) * D, D, lane, wl + WL_V + (slot ^ 8192));
        f32x16 z0, z1; qkt(z0, z1, kf, qr);
        if (j > 0) load_kfrag(kf, Kh + (size_t)(s0 - 64) * D, D, r32, hi);
        sb_tile_math(z0, z1, carry, j == jd, s0, tq, hi);
        pv(o, vp0 + slot, z0, z1);
        if (__builtin_amdgcn_ballot_w64(carry != 0.f) == 0ull) break;
        LDS_WAIT();
        slot ^= 8192;
    }
    VM_WAIT(); LDS_WAIT();
    float one[16];
#pragma unroll
    for (int r = 0; r < 16; ++r) one[r] = 1.f;
    if (!dry) store_o(o, one, wl + WL_O, O + (rowbase + t0) * D + h * 64, D, lane, r32, hi);
}

constexpr int SL_SLOT = 32768, SL_HEAD = 16384, SL_VOFF = 8192, SL_O = 98304, SL_FLAG = 131072;
static_assert(SL_FLAG + 64 <= LDSCTL_OFF, "stick-breaking LDS");
__device__ __forceinline__ void sb_prefetch(bf16x8 (&qr)[4], int b, int hp, int u, const bf16_t* Q, const bf16_t* K, const bf16_t* V, LAS char* L, int wid, int lane) {
    const int r32 = lane & 31, hi = lane >> 5; const int hh = wid >> 2, qw = wid & 3, h = 2 * hp + hh;
    const int t0 = 128 * u + 32 * qw; const size_t rowbase = (size_t)b * T; const int jtop = 2 * u + 1;
    const bf16_t* Qw = Q + (rowbase + t0) * D + h * 64; const bf16_t* Kh = K + rowbase * D + h * 64; const bf16_t* Vh = V + rowbase * D + h * 64;
    const unsigned kvoff = (unsigned)lane * 2048u, vvoff = (unsigned)((lane >> 2) * D + (lane & 3) * 8) * 2u;
    const int pa = 2 * qw, pb = 2 * qw + 1;
    const bf16_t* Kwa = Kh + pa * 8; const bf16_t* Kwb = Kh + pb * 8;
    const bf16_t* Vwa = Vh + (size_t)(16 * (pa & 3)) * D + (pa >> 2) * 32; const bf16_t* Vwb = Vh + (size_t)(16 * (pb & 3)) * D + (pb >> 2) * 32;
    const unsigned hbase = (unsigned)(size_t)L + hh * SL_HEAD;
    const unsigned kda = hbase + pa * 1024u, kdb = hbase + pb * 1024u, vda = hbase + SL_VOFF + pa * 1024u, vdb = hbase + SL_VOFF + pb * 1024u;
#pragma unroll
    for (int k = 0; k < 2; ++k) { const size_t ro_ = (size_t)(jtop - k) * 64 * D; const unsigned so_ = (unsigned)(k * SL_SLOT);
        glds16_s(Kwa + ro_, kvoff, kda + so_); glds16_s(Kwb + ro_, kvoff, kdb + so_); glds16_s(Vwa + ro_, vvoff, vda + so_); glds16_s(Vwb + ro_, vvoff, vdb + so_); }
#pragma unroll
    for (int d0 = 0; d0 < 4; ++d0) qr[d0] = *(const bf16x8*)(Qw + (size_t)r32 * D + 16 * d0 + 8 * hi);
}
__device__ __forceinline__ void sb_block_unit(bf16x8 (&qr)[4], int b, int hp  , int u  , int nb, int nhp, int nu, const bf16_t* Q, const bf16_t* K, const bf16_t* V, bf16_t* O, LAS char* L, int wid, int lane) {
    const int r32 = lane & 31, hi = lane >> 5; const int hh = wid >> 2, qw = wid & 3, h = 2 * hp + hh;
    const int t0 = 128 * u + 32 * qw; const size_t rowbase = (size_t)b * T; const int jtop = 2 * u + 1, jdw = t0 >> 6; const int tq = t0 + r32;
    const bf16_t* Kh = K + rowbase * D + h * 64; const bf16_t* Vh = V + rowbase * D + h * 64;
    const unsigned kvoff = (unsigned)lane * 2048u;
    const unsigned vvoff = (unsigned)((lane >> 2) * D + (lane & 3) * 8) * 2u;
    const int pa = 2 * qw, pb = 2 * qw + 1;
    const bf16_t* Kwa = Kh + pa * 8; const bf16_t* Kwb = Kh + pb * 8;
    const bf16_t* Vwa = Vh + (size_t)(16 * (pa & 3)) * D + (pa >> 2) * 32; const bf16_t* Vwb = Vh + (size_t)(16 * (pb & 3)) * D + (pb >> 2) * 32;
    const unsigned hbase = (unsigned)(size_t)L + hh * SL_HEAD;
    const unsigned kda = hbase + pa * 1024u, kdb = hbase + pb * 1024u, vda = hbase + SL_VOFF + pa * 1024u, vdb = hbase + SL_VOFF + pb * 1024u;
    const LAS char* kp0 = L + hh * SL_HEAD + hi * 1024 + r32 * 16;
    const LAS char* vp0 = L + hh * SL_HEAD + SL_VOFF + ((lane >> 4) & 1) * 32 + (lane & 3) * 8 + (4 * hi + ((lane & 15) >> 2)) * 64;
    LAS unsigned* flags = (LAS unsigned*)(L + SL_FLAG);
    if (lane == 0) flags[wid] = 0u;
#define SB_STAGE(j_, so_) do { const size_t ro_ = (size_t)(j_) * 64 * D; glds16_s(Kwa + ro_, kvoff, kda + (so_)); glds16_s(Kwb + ro_, kvoff, kdb + (so_)); glds16_s(Vwa + ro_, vvoff, vda + (so_)); glds16_s(Vwb + ro_, vvoff, vdb + (so_)); } while (0)
    f32x16 o[2]; o[0] = f32x16{}; o[1] = f32x16{};
    float carry = 1.f; bool gone = false;
    asm volatile("s_waitcnt vmcnt(0) lgkmcnt(0)\n\ts_barrier" ::: "memory");
    int sc = 0, sn = SL_SLOT, sn2 = 2 * SL_SLOT;
    for (int j = jtop; j >= 0; --j) {
        if (j >= 2) SB_STAGE(j - 2, (unsigned)sn2);
        if (j <= jdw && !gone) {
            bf16x8 kf[8];
#pragma unroll
            for (int d0 = 0; d0 < 4; ++d0) { kf[2 * d0] = *(const LAS bf16x8*)(kp0 + sc + d0 * 2048); kf[2 * d0 + 1] = *(const LAS bf16x8*)(kp0 + sc + d0 * 2048 + 512); }
            __builtin_amdgcn_sched_barrier(0);
            f32x16 z0, z1; qkt(z0, z1, kf, qr);
            bf16x8 vf[8]; pv_load(vf, vp0 + sc);
            __builtin_amdgcn_sched_barrier(0);
            sb_tile_math(z0, z1, carry, j == jdw, j * 64, tq, hi);
            pv_mma(o, vf, z0, z1);
            if (__builtin_amdgcn_ballot_w64(carry != 0.f) == 0ull) { gone = true; if (lane == 0) flags[wid] = 1u; }
        }
        if (j >= 2) asm volatile("s_waitcnt vmcnt(4) lgkmcnt(0)\n\ts_barrier" ::: "memory");
        else asm volatile("s_waitcnt vmcnt(0) lgkmcnt(0)\n\ts_barrier" ::: "memory");
        { const u32x4 f0 = *(const LAS u32x4*)flags, f1 = *(const LAS u32x4*)(flags + 4);
          if ((f0[0] & f0[1] & f0[2] & f0[3] & f1[0] & f1[1] & f1[2] & f1[3]) != 0u) break; }
        { const int t_ = sc; sc = sn; sn = sn2; sn2 = t_; }
    }
#undef SB_STAGE
    asm volatile("s_waitcnt vmcnt(0)" ::: "memory");
    if (nb >= 0) sb_prefetch(qr, nb, nhp, nu, Q, K, V, L, wid, lane);
    float one[16];
#pragma unroll
    for (int r = 0; r < 16; ++r) one[r] = 1.f;
    store_o(o, one, L + SL_O + wid * 4096, O + (rowbase + t0) * D + h * 64, D, lane, r32, hi);
    asm volatile("s_waitcnt lgkmcnt(0)\n\ts_barrier" ::: "memory");
}

__device__ __forceinline__ void dsa_unit(int b, int h, int qb, const bf16_t* Q, const bf16_t* K, const bf16_t* V, const unsigned long long* mask, bf16_t* O, LAS char* wl, int lane) {
    const int r32 = lane & 31, hi = lane >> 5; const int t0 = qb * 32; const size_t rowbase = (size_t)b * T; const int kvh = h >> 2;
    const bf16_t* Qw = Q + (rowbase + t0) * 512 + h * 64; const bf16_t* Kh = K + rowbase * 128 + kvh * 64; const bf16_t* Vh = V + rowbase * 128 + kvh * 64;
    const unsigned long long* mrow = mask + (rowbase + t0 + r32) * 64;
    bf16x8 qr[4];
#pragma unroll
    for (int d0 = 0; d0 < 4; ++d0) qr[d0] = *(const bf16x8*)(Qw + (size_t)r32 * 512 + 16 * d0 + 8 * hi);
    f32x16 o[2]; o[0] = f32x16{}; o[1] = f32x16{};
    float mrun = -1e30f, lsum = 0.f; const int jd = t0 >> 6;
    LAS float* wsf = (LAS float*)(wl + WL_F);
    const LAS char* vp0 = wl + WL_V + ((lane >> 4) & 1) * 32 + (lane & 3) * 8 + (4 * hi + ((lane & 15) >> 2)) * 64;
    bf16x8 kf[8];
    load_kfrag(kf, Kh, 128, r32, hi);
    dma_vtile(Vh, 128, lane, wl + WL_V);
    unsigned long long mw = mrow[0]; int slot = 0;
    for (int j = 0; j <= jd; ++j) {
        const int s0 = j * 64;
        VM_WAIT();
        if (j < jd) dma_vtile(Vh + (size_t)(s0 + 64) * 128, 128, lane, wl + WL_V + (slot ^ 8192));
        f32x16 p0, p1; qkt(p0, p1, kf, qr);
        if (j < jd) load_kfrag(kf, Kh + (size_t)(s0 + 64) * 128, 128, r32, hi);
        const unsigned long long mwn = (j < jd) ? mrow[j + 1] : 0ull;
        const unsigned mlo = (unsigned)mw >> (4 * hi), mhi = (unsigned)(mw >> 32) >> (4 * hi);
        float rm = -INFINITY;
#pragma unroll
        for (int r = 0; r < 16; ++r) { const int bit = (r & 3) + 8 * (r >> 2);
            if (!((mlo >> bit) & 1u)) p0[r] = -INFINITY; if (!((mhi >> bit) & 1u)) p1[r] = -INFINITY;
            rm = __builtin_fmaxf(rm, __builtin_fmaxf(p0[r], p1[r])); }
        rm = __builtin_fmaxf(rm, swap_other(rm, hi));
        const float mnew = __builtin_fmaxf(mrun, rm);
        const float alpha = __builtin_amdgcn_exp2f(mrun - mnew);
        float ps = 0.f;
#pragma unroll
        for (int r = 0; r < 16; ++r) { p0[r] = __builtin_amdgcn_exp2f(p0[r] - mnew); p1[r] = __builtin_amdgcn_exp2f(p1[r] - mnew); ps += p0[r] + p1[r]; }
        lsum = lsum * alpha + ps;
        if (__builtin_amdgcn_ballot_w64(mnew > mrun) != 0ull) {
            if (hi == 0) wsf[r32] = alpha;
            LDS_WAIT();
#pragma unroll
            for (int r = 0; r < 16; ++r) { const float f = wsf[crow(r, hi)]; o[0][r] *= f; o[1][r] *= f; }
        }
        mrun = mnew;
        LDS_WAIT();
        pv(o, vp0 + slot, p0, p1);
        LDS_WAIT();
        slot ^= 8192; mw = mwn;
    }
    VM_WAIT();
    lsum += swap_other(lsum, hi);
    if (hi == 0) wsf[32 + r32] = lsum;
    LDS_WAIT();
    float rli[16];
#pragma unroll
    for (int r = 0; r < 16; ++r) rli[r] = 1.0f / wsf[32 + crow(r, hi)];
    store_o(o, rli, wl + WL_O, O + (rowbase + t0) * D + h * 64, D, lane, r32, hi);
}

constexpr int IL_QF = 103424;
constexpr int DL_K = 0, DL_V = 24576, DL_O = 49152, DL_F = 81920, DL_T = 83968;
constexpr float DSA_THR = 8.0f;
__device__ __forceinline__ float max3f(float a, float b, float c) { float r; asm("v_max3_f32 %0, %1, %2, %3" : "=v"(r) : "v"(a), "v"(b), "v"(c)); return r; }
__device__ __forceinline__ float dsa_cinit(unsigned word, int bit, unsigned negm) {
    unsigned m, c; asm("v_bfe_i32 %0, %1, %2, 1" : "=v"(m) : "v"(word), "n"(bit)); asm("v_bfi_b32 %0, %1, %2, %3" : "=v"(c) : "v"(m), "v"(negm), "v"(0xFF800000u)); return __uint_as_float(c);
}
__device__ __forceinline__ void dsa_qk(f32x16& p0, f32x16& p1, const LAS char* kp, const bf16x8 (&qr)[4], unsigned long long mw, int hi, float mref, const LAS char* tbl) {
    bf16x8 kf[8];
#pragma unroll
    for (int d0 = 0; d0 < 4; ++d0) { kf[2 * d0] = *(const LAS bf16x8*)(kp + d0 * 2048); kf[2 * d0 + 1] = *(const LAS bf16x8*)(kp + d0 * 2048 + 512); }
    const unsigned mlo = (unsigned)mw >> (4 * hi), mhi = (unsigned)(mw >> 32) >> (4 * hi), negm = __float_as_uint(-mref);
    if (tbl) {
#pragma unroll
        for (int i = 0; i < 4; ++i) { const u32x4 a = *(const LAS u32x4*)(tbl + ((mlo >> (8 * i)) & 15u) * 16u), b = *(const LAS u32x4*)(tbl + ((mhi >> (8 * i)) & 15u) * 16u);
#pragma unroll
            for (int e = 0; e < 4; ++e) { p0[4 * i + e] = __uint_as_float(a[e]); p1[4 * i + e] = __uint_as_float(b[e]); } }
        __builtin_amdgcn_sched_barrier(0);
    } else {
        __builtin_amdgcn_sched_barrier(0);
#pragma unroll
        for (int r = 0; r < 16; ++r) { p0[r] = dsa_cinit(mlo, (r & 3) + 8 * (r >> 2), negm); p1[r] = dsa_cinit(mhi, (r & 3) + 8 * (r >> 2), negm); }
        __builtin_amdgcn_sched_barrier(0);
    }
#pragma unroll
    for (int d0 = 0; d0 < 4; ++d0) {
        p0 = __builtin_amdgcn_mfma_f32_32x32x16_bf16(kf[2 * d0], qr[d0], p0, 0, 0, 0);
        p1 = __builtin_amdgcn_mfma_f32_32x32x16_bf16(kf[2 * d0 + 1], qr[d0], p1, 0, 0, 0);
    }
}
__device__ __forceinline__ void dsa_step(f32x16& c0, f32x16& c1, f32x16& n0, f32x16& n1, const bool have_n, const LAS char* kpn, const LAS char* vpc, const bf16x8 (&qr)[4], unsigned long long mwn,
                                         f32x16 (&o)[2], float& mref, float& lsum, LAS float* wsf, int r32, int hi, const bool fixed, const LAS char* tblp) {
    if (have_n) dsa_qk(n0, n1, kpn, qr, mwn, hi, mref, fixed ? tblp : (const LAS char*)nullptr);
    bf16x8 vf[8]; pv_load(vf, vpc);
    __builtin_amdgcn_sched_barrier(0);
    bool resc = false; float rm = 0.f;
    if (!fixed) {
        rm = __builtin_fmaxf(c0[0], c1[0]);
#pragma unroll
        for (int r = 1; r < 16; ++r) rm = max3f(rm, c0[r], c1[r]);
        rm = __builtin_fmaxf(rm, swap_other(rm, hi));
        resc = __builtin_amdgcn_ballot_w64(rm > DSA_THR) != 0ull;
    }
    if (resc) { const float dl = __builtin_fmaxf(rm, 0.f); mref += dl; const float f = __builtin_amdgcn_exp2f(-dl); lsum *= f; if (hi == 0) wsf[r32] = f;
#pragma unroll
        for (int r = 0; r < 16; ++r) { c0[r] -= dl; c1[r] -= dl; }
        if (have_n) {
#pragma unroll
            for (int r = 0; r < 16; ++r) { n0[r] -= dl; n1[r] -= dl; } } }
    f32x2 ps2 = {0.f, 0.f};
#pragma unroll
    for (int r = 0; r < 16; r += 2) { c0[r] = __builtin_amdgcn_exp2f(c0[r]); c0[r + 1] = __builtin_amdgcn_exp2f(c0[r + 1]); c1[r] = __builtin_amdgcn_exp2f(c1[r]); c1[r + 1] = __builtin_amdgcn_exp2f(c1[r + 1]);
        ps2 += (f32x2){c0[r], c0[r + 1]}; ps2 += (f32x2){c1[r], c1[r + 1]}; }
    lsum += ps2[0] + ps2[1];
    if (resc) { LDS_WAIT();
#pragma unroll
        for (int r = 0; r < 16; ++r) { const float f = wsf[crow(r, hi)]; o[0][r] *= f; o[1][r] *= f; } }
    pv_mma(o, vf, c0, c1);
    asm volatile("s_waitcnt vmcnt(0) lgkmcnt(0)\n\ts_barrier" ::: "memory");
}
__device__ __forceinline__ void dsa_block_unit(int b, int g, int m  , const bf16_t* Q, const bf16_t* K, const bf16_t* V, const unsigned long long* mask, bf16_t* O, LAS char* L, int wid, int lane, float sbound  ) {
    const int r32 = lane & 31, hi = lane >> 5; const int h = 4 * g + (wid & 3), t0 = 64 * m + 32 * (wid >> 2); const size_t rowbase = (size_t)b * T; const int jd = m;
    const bf16_t* Qw = Q + (rowbase + t0) * 512 + h * 64; const bf16_t* Kg = K + rowbase * 128 + g * 64; const bf16_t* Vg = V + rowbase * 128 + g * 64;
    const unsigned long long* mrow = mask + (rowbase + t0 + r32) * 64;
    bf16x8 qr[4];
#pragma unroll
    for (int d0 = 0; d0 < 4; ++d0) qr[d0] = *(const bf16x8*)(Qw + (size_t)r32 * 512 + 16 * d0 + 8 * hi);
    f32x16 o[2]; o[0] = f32x16{}; o[1] = f32x16{};
    const bool fixed = sbound > 0.f;
    float mref = fixed ? sbound : 0.f, lsum = 0.f;
    LAS float* wsf = (LAS float*)(L + DL_F + wid * 256);
    const unsigned kvoff = (unsigned)lane * 256u;
    const unsigned vvoff = (unsigned)((lane >> 2) * 128 + (lane & 3) * 8) * 2u;
    const bf16_t* Kw = Kg + wid * 8; const bf16_t* Vw = Vg + (size_t)(16 * (wid & 3)) * 128 + (wid >> 2) * 32;
    const unsigned kdst = (unsigned)(size_t)(L + DL_K) + wid * 1024u, vdst = (unsigned)(size_t)(L + DL_V) + wid * 1024u;
    const LAS char* kp0 = L + DL_K + hi * 1024 + r32 * 16;
    const LAS char* vp0 = L + DL_V + ((lane >> 4) & 1) * 32 + (lane & 3) * 8 + (4 * hi + ((lane & 15) >> 2)) * 64;
    glds16_s(Kw, kvoff, kdst); glds16_s(Vw, vvoff, vdst);
    if (jd >= 1) { glds16_s(Kw + (size_t)64 * 128, kvoff, kdst + 8192); glds16_s(Vw + (size_t)64 * 128, vvoff, vdst + 8192); }
    unsigned long long mwn = mrow[0];
    unsigned long long mwn2 = (jd >= 1) ? mrow[1] : 0ull;
    asm volatile("s_waitcnt vmcnt(0) lgkmcnt(0)\n\ts_barrier" ::: "memory");
    const LAS char* tblp = L + DL_T;
    f32x16 pa0, pa1, pb0, pb1; dsa_qk(pa0, pa1, kp0, qr, mwn, hi, mref, fixed ? tblp : (const LAS char*)nullptr);
    mwn = mwn2;
    int sc = 0, sn = 8192, sn2 = 16384;
    for (int j = 0; j <= jd; j += 2) {
        if (j + 2 <= jd) { glds16_s(Kw + (size_t)(j + 2) * 64 * 128, kvoff, kdst + sn2); glds16_s(Vw + (size_t)(j + 2) * 64 * 128, vvoff, vdst + sn2); mwn2 = mrow[j + 2]; }
        dsa_step(pa0, pa1, pb0, pb1, j < jd, kp0 + sn, vp0 + sc, qr, mwn, o, mref, lsum, wsf, r32, hi, fixed, tblp);
        if (j == jd) break;
        { const int t_ = sc; sc = sn; sn = sn2; sn2 = t_; } mwn = mwn2;
        if (j + 3 <= jd) { glds16_s(Kw + (size_t)(j + 3) * 64 * 128, kvoff, kdst + sn2); glds16_s(Vw + (size_t)(j + 3) * 64 * 128, vvoff, vdst + sn2); mwn2 = mrow[j + 3]; }
        dsa_step(pb0, pb1, pa0, pa1, j + 1 < jd, kp0 + sn, vp0 + sc, qr, mwn, o, mref, lsum, wsf, r32, hi, fixed, tblp);
        { const int t_ = sc; sc = sn; sn = sn2; sn2 = t_; } mwn = mwn2;
    }
    lsum += swap_other(lsum, hi);
    if (hi == 0) wsf[32 + r32] = lsum;
    LDS_WAIT();
    float rli[16];
#pragma unroll
    for (int r = 0; r < 16; ++r) rli[r] = 1.0f / wsf[32 + crow(r, hi)];
    store_o(o, rli, L + DL_O + wid * 4096, O + (rowbase + t0) * D + h * 64, D, lane, r32, hi);
}

__device__ __forceinline__ unsigned fkey(float v) { unsigned u = __float_as_uint(v); if (u == 0x80000000u) u = 0u; return (u & 0x80000000u) ? ~u : (u | 0x80000000u); }
__device__ __forceinline__ void idx_scores_half(f32x16& sc, const bf16_t* KIt  , const LAS char* QF, const f32x4& w, int r32, int hi) {
    bf16x8 kf[4];
#pragma unroll
    for (int d0 = 0; d0 < 4; ++d0) kf[d0] = *(const bf16x8*)(KIt + (size_t)r32 * 64 + 16 * d0 + 8 * hi);
    sc = f32x16{};
#pragma unroll
    for (int h = 0; h < 4; ++h) { f32x16 p = f32x16{};
#pragma unroll
        for (int d0 = 0; d0 < 4; ++d0) p = __builtin_amdgcn_mfma_f32_32x32x16_bf16(kf[d0], *(const LAS bf16x8*)(QF + ((h * 4 + d0) * 2 + hi) * 512 + r32 * 16), p, 0, 0, 0);
#pragma unroll
        for (int r = 0; r < 16; ++r) sc[r] = fmaf(w[h], __builtin_fmaxf(p[r], 0.f), sc[r]); }
}
__device__ __forceinline__ void idx_unit(int b, int qb, const bf16_t* QI, const bf16_t* KI, const float* WI, unsigned long long* mask, LAS unsigned* hist, int tid) {
    const int lane = tid & 63, wid = __builtin_amdgcn_readfirstlane(tid >> 6), r32 = lane & 31, hi = lane >> 5;
    const int t0 = qb * 32, jd = t0 >> 6, jtop = 4 * (t0 >> 8) + 3; const size_t rowbase = (size_t)b * T; const int tq = t0 + r32;
    const size_t row = rowbase + tq;
    const LAS char* qf = (const LAS char*)hist + IL_QF;
    const f32x4 w = *(const f32x4*)(WI + row * 4);
    const bf16_t* KIb = KI + rowbase * 64;
    unsigned base = 0u, need = 256u, sthr = 4095u, jt = 0u; bool done = (t0 < 256);
    if (t0 >= 256) {
        for (int i = tid; i < 2 * 32 * 65; i += 512) hist[i] = 0u;
        __syncthreads();
        for (int stage = 0; stage < 8; ++stage) {
            LAS unsigned* HB = hist + (stage & 1) * (32 * 65);
            const int shift = stage < 5 ? 26 - 6 * stage : (stage == 5 ? 0 : (stage == 6 ? 6 : 0));
            const unsigned bmask = (stage == 5) ? 3u : 63u;
            const unsigned xmask = stage == 0 ? 0u : (stage < 6 ? (0xFFFFFFFFu << (shift + (stage == 5 ? 2 : 6))) : 0xFFFFFFFFu);
            for (int j = wid; j <= jd; j += 8) {
                const bool diag = (j == jd);
#pragma unroll 1
                for (int p = 0; p < 2; ++p) {
                    f32x16 sc; idx_scores_half(sc, KIb + (size_t)(j * 64 + 32 * p) * 64, qf, w, r32, hi);
#pragma unroll
                    for (int r = 0; r < 16; ++r) {
                        const int s = j * 64 + 32 * p + crow(r, hi); const unsigned key = fkey(sc[r]);
                        bool in = !done && (!diag || s <= tq) && (((key ^ base) & xmask) == 0u);
                        if (stage == 7) in = in && ((unsigned)j == jt);
                        const unsigned src = stage < 6 ? key : (unsigned)s;
                        const unsigned bin = (src >> shift) & bmask;
                        if (in) __hip_atomic_fetch_add(&HB[r32 * 65 + bin], 1u, __ATOMIC_RELAXED, __HIP_MEMORY_SCOPE_WORKGROUP);
                    }
                }
            }
            __syncthreads();
            if (!done) {
                const int nb = (stage == 5) ? 4 : 64; const bool desc = stage < 6;
                unsigned cum = 0u, tb = 0u, before = 0u, ctb = 0u; bool found = false;
                for (int i = 0; i < nb; ++i) { const int bidx = desc ? nb - 1 - i : i; const unsigned c = HB[r32 * 65 + bidx];
                    if (!found && cum + c >= need) { found = true; tb = (unsigned)bidx; before = cum; ctb = c; }
                    cum += c; }
                if (!found) { tb = desc ? 0u : (unsigned)(nb - 1); before = 0u; ctb = need; }
                need -= before;
                if (stage < 6) { base |= tb << shift; if (need == ctb) done = true; }
                else if (stage == 6) { jt = tb; }
                else { sthr = 64u * jt + tb; done = true; }
            }
            { LAS unsigned* HN = hist + ((stage + 1) & 1) * (32 * 65); for (int i = tid; i < 32 * 65; i += 512) HN[i] = 0u; }
            __syncthreads();
            if (__builtin_amdgcn_ballot_w64(!done) == 0ull) break;
        }
    }
    for (int j = wid; j <= jtop; j += 8) {
        unsigned lo = 0u, hw = 0u;
        if (j <= jd) {
            const bool diag = (j == jd);
#pragma unroll 1
            for (int p = 0; p < 2; ++p) {
                f32x16 sc; idx_scores_half(sc, KIb + (size_t)(j * 64 + 32 * p) * 64, qf, w, r32, hi);
                unsigned bits = 0u;
#pragma unroll
                for (int r = 0; r < 16; ++r) {
                    const int s = j * 64 + 32 * p + crow(r, hi); const unsigned key = fkey(sc[r]);
                    const bool sel = (!diag || s <= tq) && (key > base || (key == base && (unsigned)s <= sthr));
                    if (sel) bits |= 1u << crow(r, 0);
                }
                bits <<= 4 * hi;
                if (p) hw = bits; else lo = bits;
            }
        }
        lo = swap_or(lo); hw = swap_or(hw);
        if (hi == 0) mask[row * 64 + j] = (unsigned long long)lo | ((unsigned long long)hw << 32);
    }
    __syncthreads();
}

constexpr int IDX_CAP = 192, ZBIN = 160, NBINS = 320, HSTR = 321;
constexpr int IL_CNT = 0, IL_TABN = 128, IL_TABNEED = 256, IL_TABBIN = 384, IL_CAND = 512, IL_HIST = IL_CAND, IL_MASK = IL_CAND + 32 * IDX_CAP * 8, IL_Z = IL_MASK + 32 * 64 * 8, IL_END = IL_Z + 32 * 64 * 8;
static_assert(IL_QF >= IL_END && IL_QF + 16384 <= RING_BYTES, "indexer LDS (qf)");
static_assert(32 * HSTR * 4 <= 32 * IDX_CAP * 8 && (32 * HSTR * 4) % 16 == 0 && IL_END <= RING_BYTES, "indexer LDS");
__device__ __forceinline__ unsigned fkey2(float v) { const unsigned u = __float_as_uint(v + 0.0f); return u ^ ((unsigned)((int)u >> 31) | 0x80000000u); }
__device__ __forceinline__ int imed3(int a, int lo, int hi) { const int x = a > hi ? hi : a; return x < lo ? lo : x; }
__device__ __forceinline__ int ibin_u(unsigned u) {
    const int a = (int)u >> 20;
    return imed3(-953 - a, 0, 159) + imed3(a - 936, 0, 158) + imed3((int)u, -160, 1) + 160;
}
__device__ __forceinline__ int ibin_u_m160(unsigned u) {
    const int a = (int)u >> 20;
    return imed3(-953 - a, 0, 159) + imed3(a - 936, 0, 158) + imed3((int)u, -160, 1);
}
__device__ __forceinline__ unsigned keylo(int b) {
    return b <= 0 ? 0u : (b <= 159 ? (unsigned)(b + 952) << 20 : (b == 160 ? 0x80000000u : (b == 161 ? 0x80000001u : (b <= 319 ? (0x80000000u | ((unsigned)(b + 775) << 20)) : 0xFFFFFFFFu))));
}
__device__ __forceinline__ float relu_i(float p) { const int i = __float_as_int(p); return __int_as_float(i > 0 ? i : 0); }
__device__ __forceinline__ void shl_ge_f(unsigned& acc, float v, float thr) { asm("v_cmp_ge_f32 vcc, %1, %2\n\tv_addc_co_u32 %0, vcc, %0, %0, vcc" : "+v"(acc) : "v"(v), "v"(thr) : "vcc"); }
__device__ __forceinline__ float key_thr(unsigned k) {
    if (k == 0u) return __uint_as_float(0xFF800000u);
    if (k == 0xFFFFFFFFu) return __uint_as_float(0x7FC00000u);
    if (k == 0x80000001u) return __uint_as_float(0x00800000u);
    return (k & 0x80000000u) ? __uint_as_float(k ^ 0x80000000u) : __uint_as_float(~k);
}
__device__ __forceinline__ void shl_ge(unsigned& acc, unsigned key, unsigned thr) { asm("v_cmp_ge_u32 vcc, %1, %2\n\tv_addc_co_u32 %0, vcc, %0, %0, vcc" : "+v"(acc) : "v"(key), "v"(thr) : "vcc"); }
__device__ __forceinline__ unsigned spread4(unsigned x) { return (x & 0xFu) | ((x & 0xF0u) << 4) | ((x & 0xF00u) << 8) | ((x & 0xF000u) << 12); }
__device__ __forceinline__ void idx_loadk(bf16x8 (&kf)[4], const bf16_t* KIt, int r32, int hi) {
#pragma unroll
    for (int d0 = 0; d0 < 4; ++d0) kf[d0] = *(const bf16x8*)(KIt + (size_t)r32 * 64 + 16 * d0 + 8 * hi);
}
__device__ __forceinline__ void idx_scores_k(f32x16& sc, const bf16x8 (&kf)[4], const bf16x8 (&qf)[16], const f32x4& w) {
    f32x16 p0 = f32x16{}, p1 = f32x16{};
#pragma unroll
    for (int d0 = 0; d0 < 4; ++d0) p0 = __builtin_amdgcn_mfma_f32_32x32x16_bf16(kf[d0], qf[d0], p0, 0, 0, 0);
#pragma unroll
    for (int d0 = 0; d0 < 4; ++d0) p1 = __builtin_amdgcn_mfma_f32_32x32x16_bf16(kf[d0], qf[4 + d0], p1, 0, 0, 0);
#pragma unroll
    for (int r = 0; r < 16; ++r) sc[r] = w[0] * relu_i(p0[r]);
    p0 = f32x16{};
#pragma unroll
    for (int d0 = 0; d0 < 4; ++d0) p0 = __builtin_amdgcn_mfma_f32_32x32x16_bf16(kf[d0], qf[8 + d0], p0, 0, 0, 0);
#pragma unroll
    for (int r = 0; r < 16; ++r) sc[r] = fmaf(w[1], relu_i(p1[r]), sc[r]);
    p1 = f32x16{};
#pragma unroll
    for (int d0 = 0; d0 < 4; ++d0) p1 = __builtin_amdgcn_mfma_f32_32x32x16_bf16(kf[d0], qf[12 + d0], p1, 0, 0, 0);
#pragma unroll
    for (int r = 0; r < 16; ++r) sc[r] = fmaf(w[2], relu_i(p0[r]), sc[r]);
#pragma unroll
    for (int r = 0; r < 16; ++r) sc[r] = fmaf(w[3], relu_i(p1[r]), sc[r]);
}
template <int PASS, bool DIAG> __device__ __forceinline__ void idx_half(unsigned& bits, unsigned& ebits, const f32x16& sc, int sbase, int tq, int r32, int hi, unsigned khi, unsigned klo, bool cand, LAS unsigned char* L) {
    bits = 0u; ebits = 0u;
    const int d = tq - sbase - 4 * hi;
    if (PASS == 1) {
        LAS unsigned* H = (LAS unsigned*)(L + IL_HIST) + r32 * HSTR + 160;
#pragma unroll
        for (int r = 0; r < 16; ++r) { int b = ibin_u_m160(__float_as_uint(sc[r] + 0.0f)); asm("" : "+v"(b));
            if (!DIAG || crow(r, 0) <= d) __hip_atomic_fetch_add(H + b, 1u, __ATOMIC_RELAXED, __HIP_MEMORY_SCOPE_WORKGROUP); }
    } else {
        unsigned hb = 0u, lb = 0u;
#pragma unroll
        for (int r = 15; r >= 0; --r) { shl_ge_f(hb, sc[r], __uint_as_float(khi)); shl_ge_f(lb, sc[r], __uint_as_float(klo)); }
        bits = spread4(hb); ebits = spread4(lb & ~hb);
        if (DIAG) { const unsigned vm = d < 0 ? 0u : (d >= 31 ? 0xFFFFFFFFu : ((2u << d) - 1u)); bits &= vm; ebits &= vm; }
        if (cand && ebits != 0u) {
            unsigned slot = __hip_atomic_fetch_add((LAS unsigned*)(L + IL_CNT) + r32, (unsigned)__builtin_popcount(ebits), __ATOMIC_RELAXED, __HIP_MEMORY_SCOPE_WORKGROUP);
#pragma unroll
            for (int r = 0; r < 16; ++r) if ((ebits >> crow(r, 0)) & 1u) { const int s = sbase + crow(r, hi);
                if (slot < (unsigned)IDX_CAP) ((LAS unsigned long long*)(L + IL_CAND))[r32 * IDX_CAP + slot] = ((unsigned long long)fkey2(sc[r]) << 16) | (unsigned long long)(0xFFFFu - (unsigned)s);
                ++slot; }
        }
        bits <<= 4 * hi; ebits <<= 4 * hi;
    }
}
template <int PASS> __device__ __forceinline__ void idx_pass(const bf16_t* KIb, const bf16x8 (&qf)[16], const f32x4& w, int jd, int tq, int wid, int r32, int hi, unsigned khi, unsigned klo, bool cand, LAS unsigned char* L) {
    bf16x8 kA[4], kB[4];
    int j = wid;
    if (j <= jd) idx_loadk(kA, KIb + (size_t)(j * 64) * 64, r32, hi);
    for (; j <= jd; j += 8) {
        const bool diag = (j == jd);
        idx_loadk(kB, KIb + (size_t)(j * 64 + 32) * 64, r32, hi);
        f32x16 sc; idx_scores_k(sc, kA, qf, w);
        unsigned lo, elo, hw, ehw;
        if (diag) idx_half<PASS, true>(lo, elo, sc, j * 64, tq, r32, hi, khi, klo, cand, L); else idx_half<PASS, false>(lo, elo, sc, j * 64, tq, r32, hi, khi, klo, cand, L);
        if (j + 8 <= jd) idx_loadk(kA, KIb + (size_t)((j + 8) * 64) * 64, r32, hi);
        idx_scores_k(sc, kB, qf, w);
        if (diag) idx_half<PASS, true>(hw, ehw, sc, j * 64 + 32, tq, r32, hi, khi, klo, cand, L); else idx_half<PASS, false>(hw, ehw, sc, j * 64 + 32, tq, r32, hi, khi, klo, cand, L);
        if (PASS == 2) { lo = swap_or(lo); hw = swap_or(hw); elo = swap_or(elo); ehw = swap_or(ehw);
            if (hi == 0) { ((LAS unsigned long long*)(L + IL_MASK))[r32 * 64 + j] = (unsigned long long)lo | ((unsigned long long)hw << 32);
                           ((LAS unsigned long long*)(L + IL_Z))[r32 * 64 + j] = (unsigned long long)elo | ((unsigned long long)ehw << 32); } }
    }
}
template <int NC> __device__ __forceinline__ void idx_rank(LAS unsigned long long* cc, int n, unsigned nd, int lane, LAS unsigned* mrow) {
    const int n8 = (n + 7) & ~7;
    if (lane < 7 && n + lane < n8) { unsigned z; asm volatile("v_mov_b32 %0, 0" : "=v"(z)); ((LAS unsigned*)cc)[2 * (n + lane)] = z; ((LAS unsigned*)cc)[2 * (n + lane) + 1] = z; }
    LDS_WAIT();
    unsigned long long me[NC]; unsigned rank[NC];
#pragma unroll
    for (int k = 0; k < NC; ++k) { me[k] = (lane + 64 * k < n) ? cc[lane + 64 * k] : ~0ull; rank[k] = 0u; }
#pragma unroll 2
    for (int c2 = 0; c2 < n8; c2 += 8) {
        unsigned long long a[8];
#pragma unroll
        for (int i = 0; i < 8; ++i) a[i] = cc[c2 + i];
#pragma unroll
        for (int i = 0; i < 8; ++i)
#pragma unroll
            for (int k = 0; k < NC; ++k) rank[k] += (a[i] > me[k]) ? 1u : 0u;
    }
#pragma unroll
    for (int k = 0; k < NC; ++k) if (lane + 64 * k < n && rank[k] < nd) { const unsigned sI = 0xFFFFu - (unsigned)(me[k] & 0xFFFFull);
        __hip_atomic_fetch_or(mrow + (sI >> 5), 1u << (sI & 31), __ATOMIC_RELAXED, __HIP_MEMORY_SCOPE_WORKGROUP); }
}
__device__ __forceinline__ bool idx_unit_fast(int b, int qb, const bf16_t* QI, const bf16_t* KI, const float* WI, unsigned long long* mask, LAS unsigned char* L, int tid) {
    asm volatile("" : "+v"(tid));
    const int lane0 = tid & 63, wid = __builtin_amdgcn_readfirstlane(tid >> 6), r32 = lane0 & 31, hi = lane0 >> 5;
    const int t0 = qb * 32, jd = t0 >> 6, jtop = 4 * (t0 >> 8) + 3; const size_t rowbase = (size_t)b * T; const int tq = t0 + r32;
    if (t0 < 256) {
        const int r = tid >> 4, j = tid & 15, t = t0 + r;
        if (j <= jtop) { const int n = t - 64 * j + 1; const unsigned long long m = n >= 64 ? ~0ull : (n <= 0 ? 0ull : ((1ull << n) - 1ull)); mask[(rowbase + t) * 64 + j] = m; }
        return false;
    }
    const size_t row = rowbase + tq;
    if (tid < 32) ((LAS unsigned*)(L + IL_CNT))[tid] = 0u;
    for (int i = tid; i < 32 * HSTR * 4 / 16; i += 512) ((LAS u32x4*)(L + IL_HIST))[i] = (u32x4){0u, 0u, 0u, 0u};
    for (int i = tid; i < (IL_END - IL_MASK) / 16; i += 512) ((LAS u32x4*)(L + IL_MASK))[i] = (u32x4){0u, 0u, 0u, 0u};
    { const int rr = tid & 31;
#pragma unroll
      for (int k = 0; k < 2; ++k) { const int p = (tid >> 5) + 16 * k; *(LAS u32x4*)(L + IL_QF + p * 512 + rr * 16) = *(const u32x4*)(QI + (rowbase + t0 + rr) * 256 + 8 * p); } }
    const f32x4 w = *(const f32x4*)(WI + row * 4);
    const bf16_t* KIb = KI + rowbase * 64;
    __syncthreads();
    bf16x8 qf[16];
#pragma unroll
    for (int i = 0; i < 16; ++i) qf[i] = *(const LAS bf16x8*)(L + IL_QF + (i * 2 + hi) * 512 + r32 * 16);
    idx_pass<1>(KIb, qf, w, jd, tq, wid, r32, hi, 0u, 0u, false, L);
    __syncthreads();
    { const int sr = tid >> 4, sq = tid & 15, b0 = NBINS - 20 - 20 * sq; const LAS unsigned* H = (const LAS unsigned*)(L + IL_HIST) + sr * HSTR + b0;
      unsigned c[20], ssum = 0u;
#pragma unroll
      for (int i = 0; i < 20; ++i) { c[i] = H[i]; ssum += c[i]; }
      unsigned incl = ssum;
#pragma unroll
      for (int o = 1; o < 16; o <<= 1) { const unsigned v = shfl_up_u(incl, o, lane0); if (sq >= o) incl += v; }
      unsigned cum = incl - ssum;
      if (cum < 256u && incl >= 256u) { bool found = false; int tb = 0; unsigned nd = 0u, ct = 0u;
#pragma unroll
          for (int i = 19; i >= 0; --i) { if (!found && cum + c[i] >= 256u) { found = true; tb = b0 + i; nd = 256u - cum; ct = c[i]; } cum += c[i]; }
          ((LAS unsigned*)(L + IL_TABN))[sr] = ct; ((LAS unsigned*)(L + IL_TABNEED))[sr] = nd; ((LAS unsigned*)(L + IL_TABBIN))[sr] = (unsigned)tb; } }
    __syncthreads();
    const int thrbin = (int)((const LAS unsigned*)(L + IL_TABBIN))[r32]; const unsigned cthr = ((const LAS unsigned*)(L + IL_TABN))[r32];
    const bool ovf = (thrbin != ZBIN) && cthr > (unsigned)IDX_CAP;
    if (__builtin_amdgcn_ballot_w64(ovf) != 0ull) return true;
    idx_pass<2>(KIb, qf, w, jd, tq, wid, r32, hi, __float_as_uint(key_thr(keylo(thrbin + 1))), __float_as_uint(key_thr(keylo(thrbin))), thrbin != ZBIN, L);
    __syncthreads();
    asm volatile("" : "+v"(tid));
    const int lane = tid & 63;
    for (int q = 0; q < 4; ++q) { const int r = 4 * wid + q; const int n = (int)((const LAS unsigned*)(L + IL_TABN))[r]; const unsigned nd = ((const LAS unsigned*)(L + IL_TABNEED))[r];
        const bool zrow = ((const LAS unsigned*)(L + IL_TABBIN))[r] == (unsigned)ZBIN;
        if (zrow) {
            const unsigned long long z = ((const LAS unsigned long long*)(L + IL_Z))[r * 64 + lane]; const unsigned c = (unsigned)__builtin_popcountll(z);
            unsigned incl = c;
#pragma unroll
            for (int o = 1; o < 64; o <<= 1) { const unsigned v = shfl_up_u(incl, o, lane); if (lane >= o) incl += v; }
            const unsigned excl = incl - c; unsigned long long take = 0ull;
            if (incl <= nd) take = z;
            else if (excl < nd) { unsigned long long zz = z; for (unsigned k = nd - excl; k > 0u; --k) { const unsigned long long low = zz & (0ull - zz); take |= low; zz ^= low; } }
            if (take) ((LAS unsigned long long*)(L + IL_MASK))[r * 64 + lane] |= take;
        } else {
            LAS unsigned long long* cc = (LAS unsigned long long*)(L + IL_CAND) + r * IDX_CAP;
            const int nc = (n + 63) >> 6;
            if (nc <= 1) idx_rank<1>(cc, n, nd, lane, (LAS unsigned*)(L + IL_MASK) + r * 128); else if (nc == 2) idx_rank<2>(cc, n, nd, lane, (LAS unsigned*)(L + IL_MASK) + r * 128); else idx_rank<3>(cc, n, nd, lane, (LAS unsigned*)(L + IL_MASK) + r * 128);
        }
    }
    __syncthreads();
    { const int r = tid >> 4; const LAS unsigned long long* ML = (const LAS unsigned long long*)(L + IL_MASK) + r * 64; unsigned long long* MG = mask + (rowbase + t0 + r) * 64;
      for (int j = 2 * (tid & 15); j <= jtop; j += 32) { const unsigned long long w0 = ML[j], w1 = ML[j + 1]; st16_wt(MG + j, (u32x4){(unsigned)w0, (unsigned)(w0 >> 32), (unsigned)w1, (unsigned)(w1 >> 32)}); } }
    __syncthreads();
    return false;
}

template <int WND> __device__ __forceinline__ void pool_ld(u32x4 (&v)[WND], const bf16_t* U, int row, int ch8) {
    const int t = row % T;
#pragma unroll
    for (int i = 0; i < WND; ++i) { const int ri = i <= t ? i : t; v[i] = *(const u32x4*)(U + (size_t)(row - ri) * 512 + ch8 * 8); }
}
template <int WND> __device__ __forceinline__ void pool_st(const u32x4 (&v)[WND], __amdgpu_buffer_rsrc_t mix, int row, int ch8) {
    const int t = row % T; const int cnt = (t + 1 < WND) ? t + 1 : WND;
    float acc[8], cur[8];
#pragma unroll
    for (int e = 0; e < 8; ++e) acc[e] = 0.f;
#pragma unroll
    for (int i = 0; i < WND; ++i) {
#pragma unroll
        for (int e = 0; e < 4; ++e) { const unsigned wv = (i < cnt) ? v[i][e] : 0u; const float a = __uint_as_float(wv << 16), bq = __uint_as_float(wv & 0xFFFF0000u); acc[2 * e] += a; acc[2 * e + 1] += bq; if (i == 0) { cur[2 * e] = a; cur[2 * e + 1] = bq; } } }
    const float fc = (float)cnt; u32x4 o;
#pragma unroll
    for (int e = 0; e < 4; ++e) o[e] = pk2(acc[2 * e] / fc - cur[2 * e], acc[2 * e + 1] / fc - cur[2 * e + 1]);
    __builtin_amdgcn_raw_buffer_store_b128(o, mix, (row * D + 512 + ch8 * 8) * 2, 0, 16);
}
__device__ __forceinline__ void pool_rows(int row0, int nrows, const bf16_t* U, bf16_t* MIX, int tid) {
    const __amdgpu_buffer_rsrc_t mix = __builtin_amdgcn_make_buffer_rsrc((void*)MIX, 0, 0x7FFFFFFF, 0x00020000);
    const int w = __builtin_amdgcn_readfirstlane(tid >> 6), lane = tid & 63, chl = lane & 15;
    const int r0 = row0 + 8 * w + (lane >> 4), r1 = r0 + 4;
    u32x4 A[16], B[8], C[4], E2[2];
    pool_ld<16>(A, U, r0, 48 + chl);
    pool_ld<8>(B, U, r0, 32 + chl);  pool_st<16>(A, mix, r0, 48 + chl);
    pool_ld<4>(C, U, r0, 16 + chl);  pool_st<8>(B, mix, r0, 32 + chl);
    pool_ld<2>(E2, U, r0, chl);      pool_st<4>(C, mix, r0, 16 + chl);
    pool_ld<16>(A, U, r1, 48 + chl); pool_st<2>(E2, mix, r0, chl);
    pool_ld<8>(B, U, r1, 32 + chl);  pool_st<16>(A, mix, r1, 48 + chl);
    pool_ld<4>(C, U, r1, 16 + chl);  pool_st<8>(B, mix, r1, 32 + chl);
    pool_ld<2>(E2, U, r1, chl);      pool_st<4>(C, mix, r1, 16 + chl);
    pool_st<2>(E2, mix, r1, chl);
}

#ifndef REP_E2
#define REP_E2 1
#endif
#ifndef REP_E3
#define REP_E3 1
#endif
#ifndef REP_O2
#define REP_O2 1
#endif
#ifndef REP_G1
#define REP_G1 1
#endif
#ifndef REP_UP
#define REP_UP 1
#endif
#ifndef REP_DN
#define REP_DN 1
#endif
#ifndef REP_PRO
#define REP_PRO 1
#endif
#ifndef REP_QKV
#define REP_QKV 1
#endif
#ifndef REP_OUT
#define REP_OUT 1
#endif
extern __shared__ __attribute__((aligned(16))) unsigned char lds_raw[];
#define LDS0 ((LAS unsigned char*)lds_raw)
__device__ __forceinline__ void grid_barrier(int wave_s) {
    XcdBarrier b; b.bar = (unsigned*)(karg_ws() + WS_CTL) + 4096; b.x = xb_xcc_id(); b.st = (volatile LAS unsigned*)(LDS0 + MISC_OFF) + 8;
    xcd_barrier_impl(b, wave_s == 0 && lane_id() == 0);
}
__device__ __forceinline__ Frame make_frame(int wave_s) {
    Frame F; F.lds = LDS0; { int t_ = wave_s * 64 + lane_id(); asm volatile("" : "+v"(t_)); F.tid = t_; } F.lane = F.tid & 63; F.wave = wave_s;
    F.G = gridDim.x; { const int bx = blockIdx.x; F.vcu = (F.G % 8 == 0) ? (bx % 8) * (F.G / 8) + bx / 8 : bx; }
    return F;
}
template <class Epi> __device__ __forceinline__ void run_gemm(const pg8::Gemm& g, const Epi& E, int wave_s) {
    pg8::StaticOrder S; S.init(M, g.N, (int)gridDim.x, (int)blockIdx.x);
    pg8::gemm_phase<Epi, true, true>(LDS0, (LAS float*)(LDS0 + TAB_OFF), g, S, E, wave_s);
}

__global__ void __launch_bounds__(512, 2) trunk_fwd(Args args) {
    const int wave_s = __builtin_amdgcn_readfirstlane((int)threadIdx.x >> 6);
    {
        LAS unsigned char* lds0 = LDS0;
        for (int u = wave_s * 64 + lane_id(); u < (LDS_BYTES - LDSCTL_OFF) / 4; u += 512) ((LAS unsigned*)(lds0 + LDSCTL_OFF))[u] = 0u;
        __syncthreads();
        if (wave_s == 0 && lane_id() == 0) (void)xb_add(&((unsigned*)(karg_ws() + WS_CTL) + 4096)[XB_XCNT(xb_xcc_id())], 1u);
    }
#ifndef NO_PRO
    for (int rep_ = 0; rep_ < REP_PRO; ++rep_) { const Frame F = make_frame(wave_s); p0_prologue(F); }
#endif
    grid_barrier(wave_s);

#pragma unroll 1
    for (int layer = 0; layer < DEPTH; ++layer) {
        const int li = layer >> 1;
        if ((layer & 1) == 0) {
            { unsigned char* ws = karg_ws();
              pg8::Gemm g{(const bf16_t*)(ws + WS_XB), (const bf16_t*)(ws + WS_W_EIN + li * SZ_EIN), EIN, D, D, (const float*)(ws + WS_SSP)};
              pg8::EpiEvenIn E{ws, karg_in<5>() + li * 64, karg_in<6>() + li * 64};
#ifndef NO_G1
              for (int rep_ = 0; rep_ < REP_G1; ++rep_) run_gemm(g, E, wave_s);
#endif
            }
            grid_barrier(wave_s);
            { const Frame F = make_frame(wave_s); unsigned char* ws = karg_ws(); const int c = F.vcu; const int b = c >> 6, i = c & 63;
#ifndef NO_IDX
              if (F.G == 256) for (int rep_ = 0; rep_ < REP_E2; ++rep_) {
#pragma unroll 1
                  for (int k = 0; k < 2; ++k) { const int qb = k ? i : 127 - i;
                      const bool fb = idx_unit_fast(b, qb, (const bf16_t*)(ws + WS_EQI), (const bf16_t*)(ws + WS_EKI), (const float*)(ws + WS_EWI), (unsigned long long*)(ws + WS_MASK), F.lds, F.tid);
                      if (fb) idx_unit(b, qb, (const bf16_t*)(ws + WS_EQI), (const bf16_t*)(ws + WS_EKI), (const float*)(ws + WS_EWI), (unsigned long long*)(ws + WS_MASK), (LAS unsigned*)F.lds, F.tid); }
              }
#endif
#ifndef NO_POOL
              for (int r0 = c * 64; r0 < M; r0 += F.G * 64) pool_rows(r0, 64, (const bf16_t*)(ws + WS_EU), (bf16_t*)(ws + WS_EMIX), F.tid);
#endif
            }
            grid_barrier(wave_s);
#ifndef NO_DSA
            { const Frame F = make_frame(wave_s); unsigned char* ws = karg_ws(); LAS char* wl = (LAS char*)(F.lds + F.wave * WL_STRIDE); const int gw = F.vcu * 8 + F.wave, NGW = F.G * 8;
              float sbound;
              { float mq = __builtin_fabsf((karg_in<5>() + li * 64)[F.lane]), mk = __builtin_fabsf((karg_in<6>() + li * 64)[F.lane]);
#pragma unroll
                for (int o_ = 1; o_ < 64; o_ <<= 1) { mq = __builtin_fmaxf(mq, shfl_xor_f(mq, o_, F.lane)); mk = __builtin_fmaxf(mk, shfl_xor_f(mk, o_, F.lane)); }
                sbound = 64.0f * C2 * 1.03f * mq * mk; if (!(sbound <= 24.0f)) sbound = -1.0f; }
              if (F.tid < 64) { const int n_ = F.tid >> 2, e_ = F.tid & 3;
                  ((LAS unsigned*)(F.lds + DL_T))[F.tid] = ((n_ >> e_) & 1) ? __float_as_uint(-sbound) : 0xFF800000u; }
              __syncthreads();
              for (int rep_ = 0; rep_ < REP_E3; ++rep_)
              for (int p = F.vcu; p < NB * 2 * 32; p += F.G) { const int bg = p >> 5, mm = p & 31;
                  dsa_block_unit(bg >> 1, bg & 1, 63 - mm, (const bf16_t*)(ws + WS_EQ), (const bf16_t*)(ws + WS_EK), (const bf16_t*)(ws + WS_EV), (const unsigned long long*)(ws + WS_MASK), (bf16_t*)(ws + WS_EMIX), (LAS char*)F.lds, F.wave, F.lane, sbound);
                  dsa_block_unit(bg >> 1, bg & 1, mm, (const bf16_t*)(ws + WS_EQ), (const bf16_t*)(ws + WS_EK), (const bf16_t*)(ws + WS_EV), (const unsigned long long*)(ws + WS_MASK), (bf16_t*)(ws + WS_EMIX), (LAS char*)F.lds, F.wave, F.lane, sbound); } }
#endif
            grid_barrier(wave_s);
            { unsigned char* ws = karg_ws(); float* OUT = karg_out();
              pg8::Gemm g{(const bf16_t*)(ws + WS_EMIX), (const bf16_t*)(ws + WS_W_EOUT + li * SZ_SQ), D, D, D, nullptr};
              pg8::EpiRes E{(layer == 0) ? karg_in<0>() : (const float*)nullptr, (float*)nullptr, ws, false};
#ifndef NO_GRES
              for (int rep_ = 0; rep_ < REP_OUT; ++rep_) { E.dry = rep_ + 1 < REP_OUT; run_gemm(g, E, wave_s); }
#endif
            }
            grid_barrier(wave_s);
        } else {
            { const Frame F = make_frame(wave_s); quant_rows(karg_ws(), WS_XQ1, WS_SAR1, F.vcu * 8 + F.wave, F.G * 8, F.lane); }
            grid_barrier(wave_s);
            { unsigned char* ws = karg_ws();
              pg8::Gemm g{(const bf16_t*)(ws + WS_XQ1), (const bf16_t*)(ws + WS_W_OQKV + li * SZ_OQKV), 3 * D, D / 2, D / 2, (const float*)(ws + WS_SAR1)};
              pg8::EpiOddQKVq E{(bf16_t*)(ws + WS_OQ), (const float*)(ws + WS_SWQ) + (size_t)li * 3 * D};
#ifndef NO_GQKV
              for (int rep_ = 0; rep_ < REP_QKV; ++rep_) run_gemm(g, E, wave_s);
#endif
            }
            grid_barrier(wave_s);
#ifndef NO_SB
            { const Frame F = make_frame(wave_s); unsigned char* ws = karg_ws(); LAS char* wl = (LAS char*)(F.lds + F.wave * WL_STRIDE); const int gw = F.vcu * 8 + F.wave, NGW = F.G * 8;
              for (int rep_ = 0; rep_ < REP_O2; ++rep_)
              { bf16x8 qr[4]; int u = F.vcu;
                { const int u0 = u < NB * 8 * 32 ? u : 0;
                  sb_prefetch(qr, u0 >> 8, (u0 >> 5) & 7, u0 & 31, (const bf16_t*)(ws + WS_OQ), (const bf16_t*)(ws + WS_OK), (const bf16_t*)(ws + WS_OV), (LAS char*)F.lds, F.wave, F.lane); }
                for (; u < NB * 8 * 32; u += F.G) { const int bh = u >> 5, ub = u & 31; const int un = u + F.G; const bool hn = un < NB * 8 * 32;
                    sb_block_unit(qr, bh >> 3, bh & 7, ub, hn ? (un >> 8) : -1, (un >> 5) & 7, un & 31, (const bf16_t*)(ws + WS_OQ), (const bf16_t*)(ws + WS_OK), (const bf16_t*)(ws + WS_OV), (bf16_t*)(ws + WS_OQ), (LAS char*)F.lds, F.wave, F.lane); } } }
#endif
            grid_barrier(wave_s);
            { unsigned char* ws = karg_ws(); float* OUT = karg_out();
              pg8::Gemm g{(const bf16_t*)(ws + WS_OQ), (const bf16_t*)(ws + WS_W_OOUT + li * SZ_SQ), D, D, D, nullptr};
              pg8::EpiRes E{(const float*)nullptr, (float*)nullptr, ws, false};
#ifndef NO_GRES
              for (int rep_ = 0; rep_ < REP_OUT; ++rep_) { E.dry = rep_ + 1 < REP_OUT; run_gemm(g, E, wave_s); }
#endif
            }
            grid_barrier(wave_s);
        }
        { const Frame F = make_frame(wave_s); quant_rows(karg_ws(), WS_XQ, WS_SAR, F.vcu * 8 + F.wave, F.G * 8, F.lane); }
        grid_barrier(wave_s);
        { unsigned char* ws = karg_ws();
          pg8::Gemm g{(const bf16_t*)(ws + WS_XQ), (const bf16_t*)(ws + WS_W_UP + layer * SZ_UP), 2 * FF, D / 2, D / 2, (const float*)(ws + WS_SAR)};
          pg8::EpiSwiGLUq E{(bf16_t*)(ws + WS_H2), (const float*)(ws + WS_SW) + (size_t)layer * 2 * FF};
#ifndef NO_GUP
          for (int rep_ = 0; rep_ < REP_UP; ++rep_) run_gemm(g, E, wave_s);
#endif
        }
        grid_barrier(wave_s);
        { unsigned char* ws = karg_ws(); float* OUT = karg_out();
          pg8::Gemm g{(const bf16_t*)(ws + WS_H2), (const bf16_t*)(ws + WS_W_DN + layer * SZ_DN), D, FF, FF, nullptr};
          pg8::EpiRes E{(const float*)nullptr, (layer + 1 == DEPTH) ? OUT : (float*)nullptr, ws, false};
#ifndef NO_GRES
          for (int rep_ = 0; rep_ < REP_DN; ++rep_) { E.dry = rep_ + 1 < REP_DN; run_gemm(g, E, wave_s); }
#endif
        }
        if (layer + 1 < DEPTH) grid_barrier(wave_s);
    }
}

extern "C" void kernel_launch(void* const* d_in, const int* in_sizes, int n_in, void* d_out, int out_size, void* d_ws, size_t ws_size, hipStream_t stream) {
    static int grid = 0;
    if (grid == 0) {
        if (n_in != 14 || in_sizes[0] != M * D || out_size != M * D || ws_size < WS_END) { fprintf(stderr, "kernel_launch: unexpected shapes (n_in %d in0 %d out %d ws %zu); nothing launched\n", n_in, n_in > 0 ? in_sizes[0] : -1, out_size, ws_size); grid = -1; return; }
        int dev = 0, cus = 0, per_cu = 0;
        if (hipGetDevice(&dev) != hipSuccess || hipDeviceGetAttribute(&cus, hipDeviceAttributeMultiprocessorCount, dev) != hipSuccess) { grid = -1; return; }
        if (hipFuncSetAttribute((const void*)trunk_fwd, hipFuncAttributeMaxDynamicSharedMemorySize, LDS_BYTES) != hipSuccess) { fprintf(stderr, "kernel_launch: hipFuncSetAttribute failed\n"); grid = -1; return; }
        if (hipOccupancyMaxActiveBlocksPerMultiprocessor(&per_cu, (const void*)trunk_fwd, 512, LDS_BYTES) != hipSuccess || per_cu < 1) fprintf(stderr, "kernel_launch: occupancy query reports %d\n", per_cu);
        (void)hipGetLastError();
        grid = cus;
    }
    if (grid < 0) return;
    if (hipMemsetAsync((char*)d_ws + WS_CTL, 0, CTL_ZERO_BYTES, stream) != hipSuccess) return;
    Args a{};
    for (int i = 0; i < 14; ++i) a.in[i] = (const float*)d_in[i];
    a.out = (float*)d_out; a.ws = (unsigned char*)d_ws;
    hipLaunchKernelGGL(trunk_fwd, dim3(grid), dim3(512), LDS_BYTES, stream, a);
}
```

```cpp
#include <hip/hip_runtime.h>
#include <hip/hip_bf16.h>
#include <cstdio>
#include <cstdint>

#define LAS __attribute__((address_space(3)))
#define GAS __attribute__((address_space(1)))
typedef unsigned short bf16_t;
typedef short bf16x8 __attribute__((ext_vector_type(8)));
typedef short s16x4 __attribute__((ext_vector_type(4)));
typedef float f32x4 __attribute__((ext_vector_type(4)));
typedef float f32x2 __attribute__((ext_vector_type(2)));
typedef float f32x16 __attribute__((ext_vector_type(16)));
typedef unsigned u32x4 __attribute__((ext_vector_type(4)));
typedef unsigned u32x2 __attribute__((ext_vector_type(2)));

__device__ __forceinline__ float sum_rows4(float v) {
    const auto a = __builtin_amdgcn_permlane16_swap(__float_as_uint(v), __float_as_uint(v), false, false); const float s = __uint_as_float(a[0]) + __uint_as_float(a[1]);
    const auto b = __builtin_amdgcn_permlane32_swap(__float_as_uint(s), __float_as_uint(s), false, false); return __uint_as_float(b[0]) + __uint_as_float(b[1]);
}
__device__ __forceinline__ float shfl_xor_f(float v, int mask, int lane) { return __int_as_float(__builtin_amdgcn_ds_bpermute((lane ^ mask) << 2, __float_as_int(v))); }
__device__ __forceinline__ unsigned shfl_up_u(unsigned v, int o, int lane) { return (unsigned)__builtin_amdgcn_ds_bpermute(((lane >= o) ? lane - o : lane) << 2, (int)v); }
__device__ __forceinline__ int lane_id() { return (int)__builtin_amdgcn_mbcnt_hi(~0u, __builtin_amdgcn_mbcnt_lo(~0u, 0u)); }
constexpr int NB = 4, T = 4096, D = 1024, M = NB * T, FF = 2816, DEPTH = 4;
constexpr int EIN_SRC = 1604, EIN = 1792;
constexpr float EPS = 1e-6f;
constexpr float C2 = 0.125f * 1.4426950408889634f;

constexpr size_t MiB = 1u << 20;
constexpr size_t WS_CTL = 0, CTL_ZERO_BYTES = 65536;
constexpr size_t WS_W = 1 * MiB;
constexpr size_t SZ_EIN = (size_t)EIN * D * 2, SZ_SQ = (size_t)D * D * 2, SZ_OQKV = (size_t)3 * D * D * 2, SZ_UP = (size_t)2 * FF * D * 2, SZ_DN = (size_t)D * FF * 2;
constexpr size_t WS_W_EIN = WS_W;
constexpr size_t WS_W_EOUT = WS_W_EIN + 2 * SZ_EIN;
constexpr size_t WS_W_OQKV = WS_W_EOUT + 2 * SZ_SQ;
constexpr size_t WS_W_OOUT = WS_W_OQKV + 2 * SZ_OQKV;
constexpr size_t WS_W_UP = WS_W_OOUT + 2 * SZ_SQ;
constexpr size_t WS_W_DN = WS_W_UP + 4 * SZ_UP;
constexpr size_t WS_W_END = WS_W_DN + 4 * SZ_DN;
static_assert(WS_W_END == 94 * MiB, "weights");
constexpr size_t WS_XB = 94 * MiB;
constexpr size_t WS_SSP = 126 * MiB;
constexpr size_t WS_MASK = 127 * MiB;
constexpr size_t WS_ACT = 135 * MiB;
constexpr size_t WS_EQ = WS_ACT;
constexpr size_t WS_EK = WS_EQ + (size_t)M * 512 * 2;
constexpr size_t WS_EV = WS_EK + (size_t)M * 128 * 2;
constexpr size_t WS_EQI = WS_EV + (size_t)M * 128 * 2;
constexpr size_t WS_EKI = WS_EQI + (size_t)M * 256 * 2;
constexpr size_t WS_EWI = WS_EKI + (size_t)M * 64 * 2;
constexpr size_t WS_EU = WS_EWI + (size_t)M * 4 * 4;
constexpr size_t WS_EMIX = WS_EU + (size_t)M * 512 * 2;
constexpr size_t WS_OQ = WS_ACT;
constexpr size_t WS_OK = WS_OQ + (size_t)M * D * 2;
constexpr size_t WS_OV = WS_OK + (size_t)M * D * 2;
constexpr size_t WS_H2 = WS_ACT;
constexpr size_t WS_SW = 256 * 1024;
constexpr size_t WS_SWQ = 512 * 1024;
constexpr size_t WS_XQ = 224 * MiB;
constexpr size_t WS_SAR = 240 * MiB;
constexpr size_t WS_XQ1 = 232 * MiB;
constexpr size_t WS_SAR1 = 248 * MiB;
constexpr size_t WS_END = 256 * MiB;
static_assert(WS_OV + (size_t)M * D * 2 <= WS_XQ1 && WS_XQ1 + (size_t)M * D <= WS_SAR1 && WS_SAR1 + (size_t)M * 4 <= WS_END, "ws map (QKV quantisation)");
static_assert(WS_EMIX + (size_t)M * D * 2 <= WS_XQ && WS_OV + (size_t)M * D * 2 <= WS_END && WS_H2 + (size_t)M * FF * 2 <= WS_XQ && WS_XQ + (size_t)M * D <= WS_SAR && WS_SAR + (size_t)M * 4 <= WS_END && WS_SW + 4 * 2 * FF * 4 <= WS_SWQ && WS_SWQ + 2 * 3 * D * 4 <= MiB, "ws map");

constexpr int RING_BYTES = 131072;
constexpr int TAB_OFF = RING_BYTES;
constexpr int LDSCTL_OFF = TAB_OFF + 2048, MISC_OFF = LDSCTL_OFF + 320;
constexpr int LDS_BYTES = 147456;

__device__ __forceinline__ void st16_wt(void* p, u32x4 v) { asm volatile("global_store_dwordx4 %0, %1, off sc1\n\ts_nop 1" :: "v"(p), "v"(v) : "memory"); }
__device__ __forceinline__ void st8_wt(void* p, u32x2 v) { asm volatile("global_store_dwordx2 %0, %1, off sc1\n\ts_nop 1" :: "v"(p), "v"(v) : "memory"); }
namespace pg8 {
constexpr int BM = 256, BK = 64, HALF = 128, HTB = HALF * BK * 2, STAGE_BYTES = 8 * HTB, NXCD = 8, WGM = 8;
__host__ __device__ __forceinline__ int lds_byte(int r, int c) { const int st = (r >> 4) * 2 + (c >> 5), rr = r & 15, cc = c & 31, ob = rr * 64 + cc * 2; return st * 1024 + (ob ^ (((ob >> 9) & 1) << 5)); }
__host__ __device__ __forceinline__ void stage_rc(int b, int& R, int& C) { const int st = b / 1024, sb = b % 1024, swz = sb ^ (((sb >> 9) & 1) << 5); R = (st >> 1) * 16 + swz / 64; C = (st & 1) * 32 + (swz % 64) / 2; }
__host__ __device__ __forceinline__ int perm32(int rho) { const int n = rho >> 4, i = rho & 15; return 8 * (i >> 2) + 4 * n + (i & 3); }

struct Unit { int pm, pn; };
struct Gemm { const bf16_t* A; const bf16_t* Bt; int N, K, lda; const float* ssp; };

struct StaticOrder {
    int nM, nN, nwg, G, c;
    __device__ void init(int M_, int N, int G_, int c_) { nM = M_ / BM; nN = N / BM; nwg = nM * nN; G = G_; c = c_; }
    __device__ bool next(int i, Unit& u) const {
        const long L = (long)i * G + c; if (L >= nwg) return false;
        int wgid = (int)L; { const int q = nwg / NXCD, r = nwg % NXCD, xcd = wgid % NXCD, off = wgid / NXCD; wgid = (xcd < r ? xcd * (q + 1) : r * (q + 1) + (xcd - r) * q) + off; }
        const int nig = WGM * nN, gid = wgid / nig, fm = gid * WGM, gsz = (nM - fm) < WGM ? (nM - fm) : WGM;
        u.pm = fm + ((wgid % nig) % gsz); u.pn = (wgid % nig) / gsz; return true;
    }
};

__device__ __forceinline__ unsigned cvt_pk_bf16(float lo, float hi) { unsigned r; asm volatile("v_cvt_pk_bf16_f32 %0, %1, %2" : "=v"(r) : "v"(lo), "v"(hi)); return r; }

typedef f32x4 Acc[2][2][4][2];
typedef int i32x4 __attribute__((ext_vector_type(4)));
typedef i32x4 AccI[2][2][4][2];

struct EpiEvenIn {
    static constexpr bool PERM = true, NEED_RSTD = true, I8 = false; typedef f32x4 AccV;
    unsigned char* ws; const float *qg, *kg;
    __device__ __forceinline__ void operator()(const Acc& acc, const Unit& u, int wr, int wc, int fr, int fq, const LAS float* tab) const {
        const int pn = u.pn;
        bf16_t* const Q = (bf16_t*)(ws + WS_EQ); bf16_t* const K = (bf16_t*)(ws + WS_EK); bf16_t* const V = (bf16_t*)(ws + WS_EV); bf16_t* const QI = (bf16_t*)(ws + WS_EQI);
        bf16_t* const KI = (bf16_t*)(ws + WS_EKI); bf16_t* const U = (bf16_t*)(ws + WS_EU); float* const WI = (float*)(ws + WS_EWI);
        bf16_t* dst; int pitch; int mode = 0;
        if (pn < 2) { dst = Q + (4 * pn + wc) * 64; pitch = 512; mode = 1; }
        else if (pn == 2) { if (wc < 2) { dst = K + wc * 64; pitch = 128; mode = 2; } else { dst = V + (wc - 2) * 64; pitch = 128; } }
        else if (pn == 3) { dst = QI + wc * 64; pitch = 256; }
        else if (pn < 6) { dst = U + (4 * (pn - 4) + wc) * 64; pitch = 512; }
        else { dst = KI; pitch = 64; mode = (wc == 0) ? 0 : (wc == 1 ? 3 : 4); }
        if (mode == 4) return;
        f32x4 gv[2][2];
#pragma unroll
        for (int bj = 0; bj < 2; ++bj)
#pragma unroll
            for (int n = 0; n < 2; ++n) { gv[bj][n] = (f32x4){1.f, 1.f, 1.f, 1.f};
                if (mode == 1) gv[bj][n] = *(const f32x4*)(qg + 32 * bj + 8 * fq + 4 * n);
                if (mode == 2) gv[bj][n] = *(const f32x4*)(kg + 32 * bj + 8 * fq + 4 * n); }
        float rsv[2][4];
#pragma unroll
        for (int ai = 0; ai < 2; ++ai)
#pragma unroll
            for (int m = 0; m < 4; ++m) rsv[ai][m] = tab[ai * HALF + wr * 64 + m * 16 + fr];
#pragma unroll
        for (int ai = 0; ai < 2; ++ai)
#pragma unroll
            for (int m = 0; m < 4; ++m) {
                const int rl = ai * HALF + wr * 64 + m * 16 + fr; const size_t row = (size_t)u.pm * BM + rl; const float rs = rsv[ai][m];
                f32x4 v[2][2]; float ss = 0.f;
#pragma unroll
                for (int bj = 0; bj < 2; ++bj)
#pragma unroll
                    for (int n = 0; n < 2; ++n) { v[bj][n] = acc[ai][bj][m][n] * rs; const f32x4 x = v[bj][n]; ss += (x[0] * x[0] + x[1] * x[1]) + (x[2] * x[2] + x[3] * x[3]); }
                if (mode == 3) { if (fq == 0) *(f32x4*)(WI + row * 4) = v[0][0]; continue; }
                float sc = 1.f;
                if (mode == 1 || mode == 2) { ss = sum_rows4(ss); sc = rsqrtf(ss * (1.0f / 64.0f) + EPS); if (mode == 1) sc *= C2; }
#pragma unroll
                for (int bj = 0; bj < 2; ++bj) { const f32x4 a = v[bj][0] * gv[bj][0] * sc, b = v[bj][1] * gv[bj][1] * sc;
                    u32x4 w; w.x = cvt_pk_bf16(a[0], a[1]); w.y = cvt_pk_bf16(a[2], a[3]); w.z = cvt_pk_bf16(b[0], b[1]); w.w = cvt_pk_bf16(b[2], b[3]);
                    st16_wt(dst + row * pitch + 32 * bj + 8 * fq, w); }
            }
    }
};

struct EpiOddQKV {
    static constexpr bool PERM = true, NEED_RSTD = true, I8 = false; typedef f32x4 AccV;
    bf16_t* QKV;
    __device__ __forceinline__ void operator()(const Acc& acc, const Unit& u, int wr, int wc, int fr, int fq, const LAS float* tab) const {
        const int t = u.pn >> 2; const float sc0 = (t == 0) ? C2 : 1.f;
        bf16_t* base = QKV + (size_t)t * ((size_t)M * D) + (u.pn & 3) * BM + wc * 32 + 8 * fq;
        float rsv[2][4];
#pragma unroll
        for (int ai = 0; ai < 2; ++ai)
#pragma unroll
            for (int m = 0; m < 4; ++m) rsv[ai][m] = tab[ai * HALF + wr * 64 + m * 16 + fr];
#pragma unroll
        for (int ai = 0; ai < 2; ++ai)
#pragma unroll
            for (int m = 0; m < 4; ++m) {
                const int rl = ai * HALF + wr * 64 + m * 16 + fr; const size_t row = (size_t)u.pm * BM + rl; const float rs = rsv[ai][m] * sc0;
#pragma unroll
                for (int bj = 0; bj < 2; ++bj) { const f32x4 a = acc[ai][bj][m][0] * rs, b = acc[ai][bj][m][1] * rs;
                    u32x4 w; w.x = cvt_pk_bf16(a[0], a[1]); w.y = cvt_pk_bf16(a[2], a[3]); w.z = cvt_pk_bf16(b[0], b[1]); w.w = cvt_pk_bf16(b[2], b[3]);
                    st16_wt(base + row * D + bj * HALF, w); }
            }
    }
};

struct EpiOddQKVq {
    static constexpr bool PERM = true, NEED_RSTD = true, I8 = true; typedef i32x4 AccV;
    bf16_t* QKV; const float* sw;
    __device__ __forceinline__ void operator()(const AccI& acc, const Unit& u, int wr, int wc, int fr, int fq, const LAS float* tab) const {
        const int t = u.pn >> 2; const float sc0 = (t == 0) ? C2 : 1.f;
        bf16_t* base = QKV + (size_t)t * ((size_t)M * D) + (u.pn & 3) * BM + wc * 32 + 8 * fq;
        f32x4 sv[2][2];
#pragma unroll
        for (int bj = 0; bj < 2; ++bj)
#pragma unroll
            for (int n = 0; n < 2; ++n) sv[bj][n] = *(const f32x4*)(sw + u.pn * BM + bj * HALF + wc * 32 + 8 * fq + 4 * n) * sc0;
        float rsv[2][4];
#pragma unroll
        for (int ai = 0; ai < 2; ++ai)
#pragma unroll
            for (int m = 0; m < 4; ++m) rsv[ai][m] = tab[ai * HALF + wr * 64 + m * 16 + fr];
#pragma unroll
        for (int ai = 0; ai < 2; ++ai)
#pragma unroll
            for (int m = 0; m < 4; ++m) {
                const int rl = ai * HALF + wr * 64 + m * 16 + fr; const size_t row = (size_t)u.pm * BM + rl; const float rs = rsv[ai][m];
#pragma unroll
                for (int bj = 0; bj < 2; ++bj) {
                    const i32x4 ia = acc[ai][bj][m][0], ib = acc[ai][bj][m][1];
                    const f32x4 a = (f32x4){(float)ia[0], (float)ia[1], (float)ia[2], (float)ia[3]} * (sv[bj][0] * rs), b = (f32x4){(float)ib[0], (float)ib[1], (float)ib[2], (float)ib[3]} * (sv[bj][1] * rs);
                    u32x4 w; w.x = cvt_pk_bf16(a[0], a[1]); w.y = cvt_pk_bf16(a[2], a[3]); w.z = cvt_pk_bf16(b[0], b[1]); w.w = cvt_pk_bf16(b[2], b[3]);
                    st16_wt(base + row * D + bj * HALF, w); }
            }
    }
};

struct EpiSwiGLUq {
    static constexpr bool PERM = true, NEED_RSTD = true, I8 = true; typedef i32x4 AccV;
    bf16_t* H; const float* sw;
    __device__ __forceinline__ void operator()(const AccI& acc, const Unit& u, int wr, int wc, int fr, int fq, const LAS float* tab) const {
        bf16_t* base = H + u.pn * HALF + wc * 32 + 8 * fq;
        f32x4 sg[2], su[2];
#pragma unroll
        for (int n = 0; n < 2; ++n) { sg[n] = *(const f32x4*)(sw + u.pn * BM + wc * 32 + 8 * fq + 4 * n); su[n] = *(const f32x4*)(sw + u.pn * BM + HALF + wc * 32 + 8 * fq + 4 * n); }
        float rsv[2][4];
#pragma unroll
        for (int ai = 0; ai < 2; ++ai)
#pragma unroll
            for (int m = 0; m < 4; ++m) rsv[ai][m] = tab[ai * HALF + wr * 64 + m * 16 + fr];
#pragma unroll
        for (int ai = 0; ai < 2; ++ai)
#pragma unroll
            for (int m = 0; m < 4; ++m) {
                const int rl = ai * HALF + wr * 64 + m * 16 + fr; const size_t row = (size_t)u.pm * BM + rl; const float rs = rsv[ai][m];
                float o[8];
#pragma unroll
                for (int n = 0; n < 2; ++n)
#pragma unroll
                    for (int e = 0; e < 4; e += 2) {
                        const f32x2 g = (f32x2){(float)acc[ai][0][m][n][e], (float)acc[ai][0][m][n][e + 1]} * ((f32x2){sg[n][e], sg[n][e + 1]} * rs);
                        const f32x2 up = (f32x2){(float)acc[ai][1][m][n][e], (float)acc[ai][1][m][n][e + 1]} * ((f32x2){su[n][e], su[n][e + 1]} * rs);
                        f32x2 d; d.x = __builtin_amdgcn_exp2f(-g.x); d.y = __builtin_amdgcn_exp2f(-g.y); d = d + 1.0f;
                        f32x2 r; r.x = __builtin_amdgcn_rcpf(d.x); r.y = __builtin_amdgcn_rcpf(d.y); const f32x2 ov = (g * up) * r; o[4 * n + e] = ov.x; o[4 * n + e + 1] = ov.y; }
                u32x4 w; w.x = cvt_pk_bf16(o[0], o[1]); w.y = cvt_pk_bf16(o[2], o[3]); w.z = cvt_pk_bf16(o[4], o[5]); w.w = cvt_pk_bf16(o[6], o[7]);
                st16_wt(base + row * FF, w);
            }
    }
};

struct EpiRes {
    static constexpr bool PERM = true, NEED_RSTD = false, I8 = false; typedef f32x4 AccV;
    const float* base32; float* out32; unsigned char* ws; bool dry;
    __device__ __forceinline__ void operator()(const Acc& acc, const Unit& u, int wr, int wc, int fr, int fq, const LAS float* tab) const {
        bf16_t* const xb = (bf16_t*)(ws + WS_XB); float* const ssp = (float*)(ws + WS_SSP);
        const int col0 = u.pn * BM + wc * 32 + 8 * fq;
        u32x4 rb[2][4][2];
        if (!base32) {
#pragma unroll
            for (int ai = 0; ai < 2; ++ai)
#pragma unroll
                for (int m = 0; m < 4; ++m)
#pragma unroll
                    for (int bj = 0; bj < 2; ++bj) rb[ai][m][bj] = *(const u32x4*)(xb + ((size_t)u.pm * BM + ai * HALF + wr * 64 + m * 16 + fr) * D + col0 + bj * HALF);
            asm volatile("" : "+v"(rb[0][0][0]), "+v"(rb[0][0][1]), "+v"(rb[0][1][0]), "+v"(rb[0][1][1]), "+v"(rb[0][2][0]), "+v"(rb[0][2][1]), "+v"(rb[0][3][0]), "+v"(rb[0][3][1]),
                             "+v"(rb[1][0][0]), "+v"(rb[1][0][1]), "+v"(rb[1][1][0]), "+v"(rb[1][1][1]), "+v"(rb[1][2][0]), "+v"(rb[1][2][1]), "+v"(rb[1][3][0]), "+v"(rb[1][3][1]));
        }
#pragma unroll
        for (int ai = 0; ai < 2; ++ai)
#pragma unroll
            for (int m = 0; m < 4; ++m) {
                const size_t row = (size_t)u.pm * BM + ai * HALF + wr * 64 + m * 16 + fr; const size_t off = row * D + col0; float ss = 0.f;
#pragma unroll
                for (int bj = 0; bj < 2; ++bj) { f32x4 b0, b1;
                    if (base32) { b0 = *(const f32x4*)(base32 + off + bj * HALF); b1 = *(const f32x4*)(base32 + off + bj * HALF + 4); }
                    else { const u32x4 b4 = rb[ai][m][bj];
                        b0 = (f32x4){__uint_as_float(b4.x << 16), __uint_as_float(b4.x & 0xFFFF0000u), __uint_as_float(b4.y << 16), __uint_as_float(b4.y & 0xFFFF0000u)};
                        b1 = (f32x4){__uint_as_float(b4.z << 16), __uint_as_float(b4.z & 0xFFFF0000u), __uint_as_float(b4.w << 16), __uint_as_float(b4.w & 0xFFFF0000u)}; }
                    const f32x4 o0 = b0 + acc[ai][bj][m][0], o1 = b1 + acc[ai][bj][m][1];
                    if (out32 && !dry) { *(f32x4*)(out32 + off + bj * HALF) = o0; *(f32x4*)(out32 + off + bj * HALF + 4) = o1; }
                    ss += ((o0[0] * o0[0] + o0[1] * o0[1]) + (o0[2] * o0[2] + o0[3] * o0[3])) + ((o1[0] * o1[0] + o1[1] * o1[1]) + (o1[2] * o1[2] + o1[3] * o1[3]));
                    u32x4 w; w.x = cvt_pk_bf16(o0[0], o0[1]); w.y = cvt_pk_bf16(o0[2], o0[3]); w.z = cvt_pk_bf16(o1[0], o1[1]); w.w = cvt_pk_bf16(o1[2], o1[3]);
                    if (!dry) st16_wt(xb + off + bj * HALF, w); }
                ss = sum_rows4(ss);
                if (fq == 0 && !dry) ssp[row * 16 + u.pn * 4 + wc] = ss;
            }
    }
};

template <bool I8> __device__ __forceinline__ f32x4 mma16(bf16x8 b, bf16x8 a, f32x4 c) { return __builtin_amdgcn_mfma_f32_16x16x32_bf16(b, a, c, 0, 0, 0); }
template <bool I8> __device__ __forceinline__ i32x4 mma16(bf16x8 b, bf16x8 a, i32x4 c) { return __builtin_amdgcn_mfma_i32_16x16x64_i8(__builtin_bit_cast(i32x4, b), __builtin_bit_cast(i32x4, a), c, 0, 0, 0); }
template <class Epi, bool ALIGN_EPI, bool SP2>
__device__ __forceinline__ void gemm_phase(LAS unsigned char* lds, LAS float* tab, const Gemm g, const StaticOrder& S, const Epi& E, int wave_s) {
    int tid = wave_s * 64 + lane_id(); asm volatile("" : "+v"(tid));
    const int wid = __builtin_amdgcn_readfirstlane(tid >> 6), lane = tid & 63, wr = wid >> 2, wc = wid & 3, fr = lane & 15, fq = lane >> 4;
    const int K = g.K, nt = K / BK, lda = g.lda;
    unsigned voffA[2], voffB[2];
#pragma unroll
    for (int i = 0; i < 2; ++i) { int R, C; stage_rc(tid * 16 + i * 8192, R, C); const int Rb = Epi::PERM ? ((R & ~31) + perm32(R & 31)) : R;
        voffA[i] = (unsigned)(R * lda + C) * 2u; voffB[i] = (unsigned)(Rb * K + C) * 2u; }
    const size_t kstep = (size_t)(BK * 2);
    const size_t hstepA = (size_t)HALF * lda * 2, hstepB = (size_t)HALF * K * 2;
    const size_t tstepA = 2 * hstepA, tstepB = 2 * hstepB;
    const unsigned ldsw = (unsigned)wid * 1024u;
    const int aoff = lds_byte(wr * 64 + fr, fq * 8), boff = lds_byte(wc * 32 + fr, fq * 8);
#define PG8_SA(b, h) (((b) * 2 + (h)) * HTB)
#define PG8_SB(b, h) ((4 + (b) * 2 + (h)) * HTB)
#define PG8_STAGE(bufoff, gbase, voff) do { _Pragma("unroll") for (int _i = 0; _i < 2; ++_i) \
        __builtin_amdgcn_global_load_lds((const unsigned*)((const char*)(gbase) + (voff)[_i]), (LAS unsigned*)(lds + (bufoff) + ldsw + _i * 8192), 16, 0, 0); } while (0)
#define PG8_LDA(dst, b, h) do { _Pragma("unroll") for (int m = 0; m < 4; ++m) _Pragma("unroll") for (int k = 0; k < 2; ++k) dst[m][k] = *(const LAS bf16x8*)(lds + PG8_SA(b, h) + aoff + m * 2048 + k * 1024); } while (0)
#define PG8_LDB(dst, b, h) do { _Pragma("unroll") for (int n = 0; n < 2; ++n) _Pragma("unroll") for (int k = 0; k < 2; ++k) dst[n][k] = *(const LAS bf16x8*)(lds + PG8_SB(b, h) + boff + n * 2048 + k * 1024); } while (0)
#define PG8_MMA(ai, bj, At, Bt) do { __builtin_amdgcn_s_setprio(1); _Pragma("unroll") for (int m = 0; m < 4; ++m) _Pragma("unroll") for (int n = 0; n < 2; ++n) _Pragma("unroll") for (int k = 0; k < 2; ++k) \
        acc[ai][bj][m][n] = mma16<Epi::I8>(Bt[n][k], At[m][k], acc[ai][bj][m][n]); __builtin_amdgcn_s_setprio(0); } while (0)
#define PG8_WAIT_V(n) asm volatile("s_waitcnt vmcnt(" #n ")" ::: "memory")
#define PG8_WAIT_L(n) asm volatile("s_waitcnt lgkmcnt(" #n ")" ::: "memory")
#define PG8_BAR __builtin_amdgcn_s_barrier()
#define PG8_SCHED __builtin_amdgcn_sched_barrier(0)
    Unit cur, nxt; int ui = 0;
    if (!S.next(0, cur)) return;
    typedef typename Epi::AccV AccV; AccV acc[2][2][4][2];
#pragma unroll
    for (int a = 0; a < 2; ++a)
#pragma unroll
        for (int b = 0; b < 2; ++b)
#pragma unroll
            for (int m = 0; m < 4; ++m)
#pragma unroll
                for (int n = 0; n < 2; ++n) acc[a][b][m][n] = AccV{};
    bf16x8 At[4][2], B0[2][2], B1[2][2];
    const char* cA = (const char*)g.A + (size_t)cur.pm * tstepA; const char* cB = (const char*)g.Bt + (size_t)cur.pn * tstepB;
    if constexpr (SP2) {
        PG8_STAGE(PG8_SB(0, 0), cB, voffB); PG8_STAGE(PG8_SB(0, 1), cB + hstepB, voffB); PG8_STAGE(PG8_SA(0, 0), cA, voffA); PG8_STAGE(PG8_SA(0, 1), cA + hstepA, voffA);
        if (wr == 1) PG8_BAR;
        PG8_WAIT_V(2); PG8_BAR;
        PG8_STAGE(PG8_SB(1, 0), cB + kstep, voffB); PG8_STAGE(PG8_SA(1, 0), cA + kstep, voffA); PG8_STAGE(PG8_SB(1, 1), cB + hstepB + kstep, voffB);
        PG8_WAIT_V(6); PG8_BAR;
    } else {
        PG8_STAGE(PG8_SB(0, 0), cB, voffB); PG8_STAGE(PG8_SA(0, 0), cA, voffA); PG8_STAGE(PG8_SB(0, 1), cB + hstepB, voffB); PG8_STAGE(PG8_SA(0, 1), cA + hstepA, voffA);
        if (wr == 1) PG8_BAR;
        PG8_WAIT_V(4); PG8_BAR;
        PG8_STAGE(PG8_SB(1, 0), cB + kstep, voffB); PG8_STAGE(PG8_SA(1, 0), cA + kstep, voffA); PG8_STAGE(PG8_SB(1, 1), cB + hstepB + kstep, voffB);
        PG8_WAIT_V(6); PG8_BAR;
    }
    for (;;) {
        const bool has_next = S.next(ui + 1, nxt);
        if constexpr (Epi::NEED_RSTD) {
            if (Epi::I8) { if (tid < 256) tab[(ui & 1) * 256 + tid] = g.ssp[(size_t)cur.pm * BM + tid]; }
            else if (tid < 256) { const f32x4* p = (const f32x4*)(g.ssp + ((size_t)cur.pm * BM + tid) * 16); const f32x4 a = p[0], b = p[1], c = p[2], d = p[3];
                const float s = ((a[0] + a[1]) + (a[2] + a[3])) + ((b[0] + b[1]) + (b[2] + b[3])) + ((c[0] + c[1]) + (c[2] + c[3])) + ((d[0] + d[1]) + (d[2] + d[3]));
                tab[(ui & 1) * 256 + tid] = rsqrtf(s * (1.0f / D) + EPS); }
        }
        const char* nA = has_next ? (const char*)g.A + (size_t)nxt.pm * tstepA : cA; const char* nB = has_next ? (const char*)g.Bt + (size_t)nxt.pn * tstepB : cB;
        for (int t = 0; t < nt; t += 2) {
            const bool last = (t == nt - 2);
            const char* a1 = cA + (size_t)(t + 1) * kstep;
            const char* a2 = last ? nA : cA + (size_t)(t + 2) * kstep; const char* b2 = last ? nB : cB + (size_t)(t + 2) * kstep;
            const char* a3 = a2 + kstep; const char* b3 = b2 + kstep;
            if constexpr (SP2) {
            PG8_LDB(B0, 0, 0); PG8_LDB(B1, 0, 1); PG8_SCHED; PG8_LDA(At, 0, 0); PG8_STAGE(PG8_SA(1, 1), a1 + hstepA, voffA);
            PG8_WAIT_V(8); PG8_WAIT_L(0); PG8_BAR; PG8_MMA(0, 0, At, B0); PG8_MMA(0, 1, At, B1); PG8_BAR; PG8_SCHED;
            PG8_LDA(At, 0, 1); PG8_STAGE(PG8_SB(0, 0), b2, voffB); PG8_STAGE(PG8_SB(0, 1), b2 + hstepB, voffB); PG8_STAGE(PG8_SA(0, 0), a2, voffA);
            PG8_WAIT_V(8); PG8_WAIT_L(0); PG8_BAR; PG8_MMA(1, 0, At, B0); PG8_MMA(1, 1, At, B1); PG8_BAR; PG8_SCHED;
            PG8_LDB(B0, 1, 0); PG8_LDB(B1, 1, 1); PG8_SCHED; PG8_LDA(At, 1, 0); PG8_STAGE(PG8_SA(0, 1), a2 + hstepA, voffA);
            PG8_WAIT_V(8); PG8_WAIT_L(0); PG8_BAR; PG8_MMA(0, 0, At, B0); PG8_MMA(0, 1, At, B1); PG8_BAR; PG8_SCHED;
            PG8_LDA(At, 1, 1); PG8_STAGE(PG8_SB(1, 0), b3, voffB); PG8_STAGE(PG8_SB(1, 1), b3 + hstepB, voffB); PG8_STAGE(PG8_SA(1, 0), a3, voffA);
            PG8_WAIT_V(8); PG8_WAIT_L(0); PG8_BAR; PG8_MMA(1, 0, At, B0); PG8_MMA(1, 1, At, B1); PG8_BAR; PG8_SCHED;
            } else {
            PG8_LDB(B0, 0, 0); PG8_SCHED; PG8_LDA(At, 0, 0); PG8_STAGE(PG8_SA(1, 1), a1 + hstepA, voffA);
            PG8_WAIT_L(8); PG8_BAR; PG8_WAIT_L(0); PG8_MMA(0, 0, At, B0); PG8_BAR; PG8_SCHED;
            PG8_LDB(B1, 0, 1); PG8_STAGE(PG8_SB(0, 0), b2, voffB);
            PG8_BAR; PG8_WAIT_L(0); PG8_MMA(0, 1, At, B1); PG8_BAR;
            PG8_LDA(At, 0, 1); PG8_STAGE(PG8_SA(0, 0), a2, voffA);
            PG8_BAR; PG8_WAIT_L(0); PG8_MMA(1, 0, At, B0); PG8_BAR; PG8_SCHED;
            PG8_STAGE(PG8_SB(0, 1), b2 + hstepB, voffB);
            PG8_WAIT_V(6); PG8_BAR; PG8_MMA(1, 1, At, B1); PG8_BAR;
            PG8_LDB(B0, 1, 0); PG8_SCHED; PG8_LDA(At, 1, 0); PG8_STAGE(PG8_SA(0, 1), a2 + hstepA, voffA);
            PG8_WAIT_L(8); PG8_BAR; PG8_WAIT_L(0); PG8_MMA(0, 0, At, B0); PG8_BAR; PG8_SCHED;
            PG8_LDB(B1, 1, 1); PG8_STAGE(PG8_SB(1, 0), b3, voffB);
            PG8_BAR; PG8_WAIT_L(0); PG8_MMA(0, 1, At, B1); PG8_BAR;
            PG8_LDA(At, 1, 1); PG8_STAGE(PG8_SA(1, 0), a3, voffA);
            PG8_BAR; PG8_WAIT_L(0); PG8_MMA(1, 0, At, B0); PG8_BAR; PG8_SCHED;
            PG8_STAGE(PG8_SB(1, 1), b3 + hstepB, voffB);
            PG8_WAIT_V(6); PG8_BAR; PG8_MMA(1, 1, At, B1); PG8_BAR;
            }
        }
        if constexpr (ALIGN_EPI) { if (wr == 0) PG8_BAR; }
        E(acc, cur, wr, wc, fr, fq, (const LAS float*)(tab + (ui & 1) * 256));
        if (!has_next) break;
#pragma unroll
        for (int a = 0; a < 2; ++a)
#pragma unroll
            for (int b = 0; b < 2; ++b)
#pragma unroll
                for (int m = 0; m < 4; ++m)
#pragma unroll
                    for (int n = 0; n < 2; ++n) acc[a][b][m][n] = AccV{};
        cur = nxt; cA = nA; cB = nB; ++ui;
        if constexpr (ALIGN_EPI) { if (wr == 1) PG8_BAR; }
    }
    PG8_WAIT_V(0);
    if constexpr (!ALIGN_EPI) { if (wr == 0) PG8_BAR; }
    PG8_BAR;
#undef PG8_SA
#undef PG8_SB
#undef PG8_STAGE
#undef PG8_LDA
#undef PG8_LDB
#undef PG8_MMA
#undef PG8_WAIT_V
#undef PG8_WAIT_L
#undef PG8_BAR
#undef PG8_SCHED
}
}

typedef GAS unsigned gu32;
#define RLX_AGENT __ATOMIC_RELAXED, __HIP_MEMORY_SCOPE_AGENT
#define LDS_WAIT() asm volatile("s_waitcnt lgkmcnt(0)" ::: "memory")
#define VM_WAIT() asm volatile("s_waitcnt vmcnt(0)" ::: "memory")
__device__ __forceinline__ unsigned f2bf(float f) { unsigned u = __builtin_bit_cast(unsigned, f); return (u + 0x7fffu + ((u >> 16) & 1u)) >> 16; }
__device__ __forceinline__ unsigned pk2(float lo, float hi) { return f2bf(lo) | (f2bf(hi) << 16); }
__device__ __forceinline__ float bf2f(unsigned short b) { return __builtin_bit_cast(float, (unsigned)b << 16); }

#define XB_TMO      128
#define XB_XCNT(j)  (256  + 64 * (j))
#define XB_XSUB(j)  (1280 + 64 * (j))
#define XB_XGEN(j)  (2304 + 64 * (j))
#define XB_TOP      3328
#define XB_TOPGEN   3392
#define XCD_BAR_WORDS 3456
#define XB_SPIN_CAP (1u << 18)
__device__ __forceinline__ unsigned xb_ld(unsigned* p)              { return __hip_atomic_load(p, __ATOMIC_RELAXED, __HIP_MEMORY_SCOPE_AGENT); }
__device__ __forceinline__ unsigned xb_add(unsigned* p, unsigned v) { return __hip_atomic_fetch_add(p, v, __ATOMIC_RELAXED, __HIP_MEMORY_SCOPE_AGENT); }
__device__ __forceinline__ unsigned xb_xcc_id() { return (unsigned)__builtin_amdgcn_s_getreg((3 << 11) | 20) & 0xFu; }
#define XB_SPIN(cond, bar) do { unsigned _sp = 0; while (cond) { __builtin_amdgcn_s_sleep(1); \
    if ((++_sp & 255u) == 0u) { if (xb_ld(&(bar)[XB_TMO])) break; if (_sp > XB_SPIN_CAP) { atomicAdd(&(bar)[XB_TMO], 1u); break; } } } } while (0)
struct XcdBarrier { unsigned* bar; unsigned x; volatile LAS unsigned* st; };
__device__ __forceinline__ void xcd_barrier_complete(unsigned* bar, unsigned x, unsigned& nloc, unsigned& nx) {
    const unsigned G = gridDim.x * gridDim.y * gridDim.z;
    unsigned sum, cnt, mine, sp = 0u;
    for (;;) {
        sum = 0u; cnt = 0u; mine = 0u;
#pragma unroll
        for (unsigned j = 0; j < 16; ++j) { const unsigned c = xb_ld(&bar[XB_XCNT(j)]); sum += c; cnt += (c > 0u) ? 1u : 0u; mine = (j == x) ? c : mine; }
        if (sum == G) break;
        __builtin_amdgcn_s_sleep(1);
        if ((++sp & 255u) == 0u) { if (xb_ld(&bar[XB_TMO])) break; if (sp > XB_SPIN_CAP) { atomicAdd(&bar[XB_TMO], 1u); break; } }
    }
    nloc = mine > 0u ? mine : 1u; nx = cnt > 0u ? cnt : 1u;
}
__device__ __forceinline__ void xcd_barrier_impl(const XcdBarrier& b, bool leader) {
    asm volatile("s_waitcnt vmcnt(0)" ::: "memory");
    __syncthreads();
    if (leader) {
        unsigned* bar = b.bar;
        __builtin_amdgcn_s_waitcnt(0);
        unsigned nloc = b.st[0], nx = b.st[1];
        if (nloc == 0u) { xcd_barrier_complete(bar, b.x, nloc, nx); b.st[0] = nloc; b.st[1] = nx; }
        const unsigned old = xb_add(&bar[XB_XSUB(b.x)], 1u);
        const unsigned gen = old / nloc;
        if (old + 1u == (gen + 1u) * nloc) {
            __builtin_amdgcn_fence(__ATOMIC_RELEASE, "agent");
            asm volatile("s_waitcnt vmcnt(0)" ::: "memory");
            const unsigned og = xb_add(&bar[XB_TOP], 1u);
            const unsigned tg = og / nx;
            if (og + 1u == (tg + 1u) * nx) xb_add(&bar[XB_TOPGEN], 1u);
            else XB_SPIN(xb_ld(&bar[XB_TOPGEN]) == tg, bar);
            __builtin_amdgcn_fence(__ATOMIC_ACQUIRE, "agent");
            xb_add(&bar[XB_XGEN(b.x)], 1u);
            asm volatile("s_waitcnt vmcnt(0)" ::: "memory");
        } else {
            XB_SPIN(xb_ld(&bar[XB_XGEN(b.x)]) == gen, bar);
            __builtin_amdgcn_fence(__ATOMIC_ACQUIRE, "agent");
            asm volatile("s_waitcnt vmcnt(0)" ::: "memory");
        }
    }
    __syncthreads();
}

struct Args { const float* in[14]; float* out; unsigned char* ws; };
template <int SLOT> __device__ __forceinline__ unsigned long long karg_u64() {
#if defined(__HIP_DEVICE_COMPILE__)
    auto ka = __builtin_amdgcn_kernarg_segment_ptr(); unsigned long long v;
    asm volatile("s_load_dwordx2 %0, %1, %2\n\ts_waitcnt lgkmcnt(0)" : "=s"(v) : "s"(ka), "i"(SLOT * 8) : "memory");
    return v;
#else
    return 0ull;
#endif
}
template <int I> __device__ __forceinline__ const float* karg_in() { return (const float*)(const GAS float*)karg_u64<I>(); }
__device__ __forceinline__ float* karg_out() { return (float*)(GAS float*)karg_u64<14>(); }
__device__ __forceinline__ unsigned char* karg_ws() { return (unsigned char*)(GAS unsigned char*)karg_u64<15>(); }
struct Frame {
    LAS unsigned char* lds; int tid, lane, wave, vcu, G;
};


__device__ __forceinline__ float wave_sum(float v) {
#pragma unroll
    for (int o = 1; o < 64; o <<= 1) v += __shfl_xor(v, o);
    return v;
}

__device__ __forceinline__ void pool_item(const float* Wo, const float* P, const float* sc, bf16_t* WT, int k0, int n0, LAS float* scr, int lane) {
    const int c4 = lane & 7, g = (k0 - 512) >> 7, cb = ((k0 - 512) & 127) + (lane >> 3);
    const float* s = sc + 128 * g; const float* w = Wo + (size_t)(512 + 128 * g) * D + n0 + 4 * c4; const float* pp = P + ((size_t)g * 128 + cb) * 128;
    f32x4 acc[8];
#pragma unroll
    for (int i = 0; i < 8; ++i) acc[i] = (f32x4){0.f, 0.f, 0.f, 0.f};
#pragma unroll 2
    for (int d = 0; d < 128; d += 4) {
        const f32x4 s4 = *(const f32x4*)(s + d);
        f32x4 wv[4], p4[8];
#pragma unroll
        for (int j = 0; j < 4; ++j) wv[j] = *(const f32x4*)(w + (size_t)(d + j) * D);
#pragma unroll
        for (int i = 0; i < 8; ++i) p4[i] = *(const f32x4*)(pp + (size_t)(8 * i) * 128 + d);
#pragma unroll
        for (int i = 0; i < 8; ++i)
#pragma unroll
            for (int j = 0; j < 4; ++j) { const float ps = p4[i][j] * s4[j]; acc[i][0] = fmaf(ps, wv[j][0], acc[i][0]); acc[i][1] = fmaf(ps, wv[j][1], acc[i][1]); acc[i][2] = fmaf(ps, wv[j][2], acc[i][2]); acc[i][3] = fmaf(ps, wv[j][3], acc[i][3]); }
    }
#pragma unroll
    for (int i = 0; i < 8; ++i) { const int kk = 8 * i + (lane >> 3); LAS float* dd = scr + kk * 33 + 4 * c4; dd[0] = acc[i][0]; dd[1] = acc[i][1]; dd[2] = acc[i][2]; dd[3] = acc[i][3]; }
    LDS_WAIT(); asm volatile("" ::: "memory");
    const int c = lane & 7;
#pragma unroll
    for (int j = 0; j < 4; ++j) { const int n = (lane >> 3) + 8 * j; const LAS float* sp = scr + (8 * c) * 33 + n;
        u32x4 o; o.x = pk2(sp[0 * 33], sp[1 * 33]); o.y = pk2(sp[2 * 33], sp[3 * 33]); o.z = pk2(sp[4 * 33], sp[5 * 33]); o.w = pk2(sp[6 * 33], sp[7 * 33]);
        *(GAS u32x4*)(WT + (size_t)(n0 + n) * D + k0 + 8 * c) = o; }
    LDS_WAIT(); asm volatile("" ::: "memory");
}
template <class F> __device__ __forceinline__ void tr_item(const F& f, bf16_t* WT, int Kd, int k0, int n0, LAS float* scr, int lane) {
    const int c4 = lane & 7;
#pragma unroll
    for (int i = 0; i < 8; ++i) { const int kk = 8 * i + (lane >> 3); const f32x4 v = f(k0 + kk, n0 + 4 * c4); LAS float* d = scr + kk * 33 + 4 * c4; d[0] = v[0]; d[1] = v[1]; d[2] = v[2]; d[3] = v[3]; }
    LDS_WAIT(); asm volatile("" ::: "memory");
    const int c = lane & 7;
#pragma unroll
    for (int j = 0; j < 4; ++j) { const int n = (lane >> 3) + 8 * j; const LAS float* s = scr + (8 * c) * 33 + n;
        u32x4 o; o.x = pk2(s[0 * 33], s[1 * 33]); o.y = pk2(s[2 * 33], s[3 * 33]); o.z = pk2(s[4 * 33], s[5 * 33]); o.w = pk2(s[6 * 33], s[7 * 33]);
        *(GAS u32x4*)(WT + (size_t)(n0 + n) * Kd + k0 + 8 * c) = o; }
    LDS_WAIT(); asm volatile("" ::: "memory");
}
__device__ __forceinline__ int ein_src(int np) {
    const int pn = np >> 8, cl = np & 255, bj = cl >> 7, wc = (cl >> 5) & 3, i = cl & 31;
    const int L = 256 * pn + 64 * wc + 32 * bj + i;
    if (L < 1024) return L;
    if (L < 1536) return 1092 + (L - 1024);
    if (L < 1600) return 1024 + (L - 1536);
    if (L < 1604) return 1088 + (L - 1600);
    return -1;
}
struct FEin { const float* W; const float* g; __device__ __forceinline__ f32x4 operator()(int k, int np) const { const int s = ein_src(np); if (s < 0) return (f32x4){0.f, 0.f, 0.f, 0.f}; return *(const f32x4*)(W + (size_t)k * EIN_SRC + s) * g[k]; } };
struct FPlain { const float* W; int N; const float* g; __device__ __forceinline__ f32x4 operator()(int k, int np) const { const f32x4 v = *(const f32x4*)(W + (size_t)k * N + np); return g ? v * g[k] : v; } };
struct FUp { const float* W; const float* g; __device__ __forceinline__ f32x4 operator()(int k, int np) const {
    const int pn = np >> 8, j = np & 127; return *(const f32x4*)(W + (size_t)k * FF + 128 * pn + j) * g[k]; } };
struct FPool { const float* Wo; const float* P; const float* sc; __device__ __forceinline__ f32x4 operator()(int k, int n) const {
    const int g = (k - 512) >> 7, c = (k - 512) & 127; const float* p = P + ((size_t)g * 128 + c) * 128; const float* s = sc + 128 * g; const float* w = Wo + (size_t)(512 + 128 * g) * D + n;
    f32x4 a = {0.f, 0.f, 0.f, 0.f};
#pragma unroll 8
    for (int d = 0; d < 128; ++d) { const float ps = p[d] * s[d]; const f32x4 wv = *(const f32x4*)(w + (size_t)d * D); a[0] = fmaf(ps, wv[0], a[0]); a[1] = fmaf(ps, wv[1], a[1]); a[2] = fmaf(ps, wv[2], a[2]); a[3] = fmaf(ps, wv[3], a[3]); }
    return a; } };

struct TrDesc { const float* W; const float* g; bf16_t* dst; int srcN, Kd, k0, n0, kind; };
__device__ __forceinline__ void tr_decode(int r, TrDesc& d, unsigned char* ws) {
    constexpr int I_EOUT = (512 / 64) * (D / 32), I_EIN = (D / 64) * (EIN / 32), I_OQKV = (D / 64) * (3 * D / 32), I_OOUT = (D / 64) * (D / 32), I_UP = (D / 64) * (2 * FF / 32), I_DN = (FF / 64) * (D / 32);
    d.g = nullptr; d.kind = 0; d.Kd = D;
    if (r < 2 * I_EOUT) { const int l = r / I_EOUT; r %= I_EOUT; const int nblk = D / 32; d.k0 = 64 * (r / nblk); d.n0 = 32 * (r % nblk);
        d.W = karg_in<4>() + (size_t)l * D * D; d.srcN = D; d.dst = (bf16_t*)(ws + WS_W_EOUT + l * SZ_SQ); return; } r -= 2 * I_EOUT;
    if (r < 2 * I_EIN) { const int l = r / I_EIN; r %= I_EIN; const int nblk = EIN / 32; d.k0 = 64 * (r / nblk); d.n0 = 32 * (r % nblk);
        d.W = karg_in<3>() + (size_t)l * D * EIN_SRC; d.srcN = EIN_SRC; d.g = karg_in<1>() + (size_t)(2 * l) * D; d.kind = 1; d.dst = (bf16_t*)(ws + WS_W_EIN + l * SZ_EIN); return; } r -= 2 * I_EIN;
    if (r < 2 * I_OOUT) { const int l = r / I_OOUT; r %= I_OOUT; const int nblk = D / 32; d.k0 = 64 * (r / nblk); d.n0 = 32 * (r % nblk);
        d.W = karg_in<10>() + (size_t)l * D * D; d.srcN = D; d.dst = (bf16_t*)(ws + WS_W_OOUT + l * SZ_SQ); return; } r -= 2 * I_OOUT;
    { const int l = r / I_DN; r %= I_DN; const int nblk = D / 32; d.k0 = 64 * (r / nblk); d.n0 = 32 * (r % nblk);
        d.W = karg_in<13>() + (size_t)l * FF * D; d.srcN = D; d.Kd = FF; d.dst = (bf16_t*)(ws + WS_W_DN + l * SZ_DN); }
}
__device__ __forceinline__ void tr_load(const TrDesc& d, f32x4 (&v)[8], float (&gv)[8], int lane) {
    const int np = d.n0 + 4 * (lane & 7);
    const int col = d.kind == 0 ? np : (d.kind == 1 ? ein_src(np) : 128 * (np >> 8) + (np & 127));
    const int colc = col >= 0 ? col : 0;
    const float* gp = d.g ? d.g : d.W;
#pragma unroll
    for (int i = 0; i < 8; ++i) { const int k = d.k0 + 8 * i + (lane >> 3); v[i] = *(const f32x4*)(d.W + (size_t)k * d.srcN + colc); gv[i] = gp[k]; }
}
__device__ __forceinline__ void tr_store(const TrDesc& d, const f32x4 (&v)[8], const float (&gv)[8], LAS float* scr, int lane) {
    const int c4 = lane & 7;
    const int np = d.n0 + 4 * c4; const bool pad = d.kind == 1 && ein_src(np) < 0; const bool hasg = d.g != nullptr;
#pragma unroll
    for (int i = 0; i < 8; ++i) { const int kk = 8 * i + (lane >> 3); LAS float* p = scr + kk * 33 + 4 * c4; const float gm = pad ? 0.f : (hasg ? gv[i] : 1.f);
        p[0] = v[i][0] * gm; p[1] = v[i][1] * gm; p[2] = v[i][2] * gm; p[3] = v[i][3] * gm; }
    LDS_WAIT(); asm volatile("" ::: "memory");
    const int c = lane & 7;
#pragma unroll
    for (int j = 0; j < 4; ++j) { const int n = (lane >> 3) + 8 * j; const LAS float* s = scr + (8 * c) * 33 + n;
        u32x4 o; o.x = pk2(s[0 * 33], s[1 * 33]); o.y = pk2(s[2 * 33], s[3 * 33]); o.z = pk2(s[4 * 33], s[5 * 33]); o.w = pk2(s[6 * 33], s[7 * 33]);
        *(GAS u32x4*)(d.dst + (size_t)(d.n0 + n) * d.Kd + d.k0 + 8 * c) = o; }
    LDS_WAIT(); asm volatile("" ::: "memory");
}
constexpr int N_STRIPS = 2 * FF / 32;
__device__ __forceinline__ void q8_strip(const float* W, int pitch, const float* g, signed char* dst, float* sw, int n0, LAS float* scr, int lane, float swm = 1.0f  ) {
    const int kr = lane >> 3;
    f32x4 mx = {0.f, 0.f, 0.f, 0.f};
#pragma unroll 2
    for (int kb = 0; kb < D / 64; ++kb) {
#pragma unroll
        for (int i = 0; i < 8; ++i) { const int k = 64 * kb + 8 * i + kr; const f32x4 v = *(const f32x4*)(W + (size_t)k * pitch) * g[k];
            mx[0] = __builtin_fmaxf(mx[0], __builtin_fabsf(v[0])); mx[1] = __builtin_fmaxf(mx[1], __builtin_fabsf(v[1])); mx[2] = __builtin_fmaxf(mx[2], __builtin_fabsf(v[2])); mx[3] = __builtin_fmaxf(mx[3], __builtin_fabsf(v[3])); } }
#pragma unroll
    for (int c = 0; c < 4; ++c) { float m = mx[c]; m = __builtin_fmaxf(m, shfl_xor_f(m, 8, lane)); m = __builtin_fmaxf(m, shfl_xor_f(m, 16, lane)); m = __builtin_fmaxf(m, shfl_xor_f(m, 32, lane)); mx[c] = m; }
    f32x4 inv, step;
#pragma unroll
    for (int c = 0; c < 4; ++c) { step[c] = mx[c] > 0.f ? mx[c] * (1.0f / 127.0f) : 1.0f; inv[c] = mx[c] > 0.f ? 127.0f / mx[c] : 0.f; }
    if (lane < 8) *(f32x4*)(sw + n0 + 4 * lane) = step * swm;
    for (int kb = 0; kb < D / 64; ++kb) {
#pragma unroll
        for (int i = 0; i < 8; ++i) { const int kk = 8 * i + kr; const int k = 64 * kb + kk; const f32x4 v = *(const f32x4*)(W + (size_t)k * pitch) * g[k];
            LAS float* p = scr + kk * 33 + 4 * (lane & 7); p[0] = __builtin_rintf(v[0] * inv[0]); p[1] = __builtin_rintf(v[1] * inv[1]); p[2] = __builtin_rintf(v[2] * inv[2]); p[3] = __builtin_rintf(v[3] * inv[3]); }
        LDS_WAIT(); asm volatile("" ::: "memory");
        const int c = lane & 7;
#pragma unroll
        for (int j = 0; j < 4; ++j) { const int n = (lane >> 3) + 8 * j; const LAS float* sp = scr + (8 * c) * 33 + n;
            u32x2 o;
            o.x = ((unsigned)(int)sp[0 * 33] & 0xFFu) | (((unsigned)(int)sp[1 * 33] & 0xFFu) << 8) | (((unsigned)(int)sp[2 * 33] & 0xFFu) << 16) | (((unsigned)(int)sp[3 * 33] & 0xFFu) << 24);
            o.y = ((unsigned)(int)sp[4 * 33] & 0xFFu) | (((unsigned)(int)sp[5 * 33] & 0xFFu) << 8) | (((unsigned)(int)sp[6 * 33] & 0xFFu) << 16) | (((unsigned)(int)sp[7 * 33] & 0xFFu) << 24);
            *(GAS u32x2*)(dst + (size_t)(n0 + n) * D + 64 * kb + 8 * c) = o; }
        LDS_WAIT(); asm volatile("" ::: "memory");
    }
}
__device__ __forceinline__ void up_strip(int layer, int strip, unsigned char* ws, LAS float* scr, int lane) {
    const int n0 = 32 * strip; const float* w1p = karg_in<11>(); const float* w3p = karg_in<12>();
    const float* W = (((n0 >> 7) & 1) ? w3p : w1p) + (size_t)layer * D * FF + 128 * (n0 >> 8) + (n0 & 127) + 4 * (lane & 7);
    q8_strip(W, FF, karg_in<2>() + (size_t)layer * D, (signed char*)(ws + WS_W_UP + layer * SZ_UP), (float*)(ws + WS_SW) + (size_t)layer * 2 * FF, n0, scr, lane, ((n0 >> 7) & 1) ? 0.6931471805599453f : 1.4426950408889634f);
}
constexpr int Q_STRIPS = 3 * D / 32;
__device__ __forceinline__ void qkv_strip(int l, int strip, unsigned char* ws, LAS float* scr, int lane) {
    const int n0 = 32 * strip;
    q8_strip(karg_in<9>() + (size_t)l * D * 3 * D + n0 + 4 * (lane & 7), 3 * D, karg_in<1>() + (size_t)(2 * l + 1) * D, (signed char*)(ws + WS_W_OQKV + l * SZ_OQKV), (float*)(ws + WS_SWQ) + (size_t)l * 3 * D, n0, scr, lane);
}
__device__ __forceinline__ void quant_rows(unsigned char* ws, size_t xq_off, size_t sar_off, int gw, int NGW, int lane) {
    const bf16_t* xb = (const bf16_t*)(ws + WS_XB); signed char* xq = (signed char*)(ws + xq_off); float* sar = (float*)(ws + sar_off); const float* ssp = (const float*)(ws + WS_SSP);
    for (int m = gw; m < M; m += 8 * NGW) {
        u32x4 a[8][2]; float mx[8];
#pragma unroll
        for (int q = 0; q < 8; ++q) { const u32x4* p = (const u32x4*)(xb + (size_t)(m + q * NGW) * D + 16 * lane); a[q][0] = p[0]; a[q][1] = p[1]; }
        float ssv = 0.f;
        if (lane < 32) { const f32x4 s4 = *(const f32x4*)(ssp + (size_t)(m + (lane >> 2) * NGW) * 16 + 4 * (lane & 3)); ssv = (s4[0] + s4[1]) + (s4[2] + s4[3]); }
        ssv += shfl_xor_f(ssv, 1, lane); ssv += shfl_xor_f(ssv, 2, lane);
#pragma unroll
        for (int q = 0; q < 8; ++q) { float t = 0.f;
#pragma unroll
            for (int i = 0; i < 8; ++i) { const unsigned wd = a[q][i >> 2][i & 3]; t = __builtin_fmaxf(t, __builtin_fmaxf(__builtin_fabsf(__uint_as_float(wd << 16)), __builtin_fabsf(__uint_as_float(wd & 0xFFFF0000u)))); }
            mx[q] = t; }
#pragma unroll
        for (int o = 1; o < 64; o <<= 1) {
#pragma unroll
            for (int q = 0; q < 8; ++q) mx[q] = __builtin_fmaxf(mx[q], shfl_xor_f(mx[q], o, lane)); }
        float mysar = 0.f;
#pragma unroll
        for (int q = 0; q < 8; ++q) { const int row = m + q * NGW;
            const float inv = mx[q] > 0.f ? 127.0f / mx[q] : 0.f, step = mx[q] > 0.f ? mx[q] * (1.0f / 127.0f) : 1.0f;
            if (lane == 4 * q) mysar = rsqrtf(ssv * (1.0f / D) + EPS) * step;
            u32x4 o4;
#pragma unroll
            for (int w4 = 0; w4 < 4; ++w4) { const unsigned w0 = a[q][w4 >> 1][2 * (w4 & 1)], w1 = a[q][w4 >> 1][2 * (w4 & 1) + 1];
                const int q0 = (int)__builtin_rintf(__uint_as_float(w0 << 16) * inv), q1 = (int)__builtin_rintf(__uint_as_float(w0 & 0xFFFF0000u) * inv);
                const int q2 = (int)__builtin_rintf(__uint_as_float(w1 << 16) * inv), q3 = (int)__builtin_rintf(__uint_as_float(w1 & 0xFFFF0000u) * inv);
                o4[w4] = ((unsigned)q0 & 0xFFu) | (((unsigned)q1 & 0xFFu) << 8) | (((unsigned)q2 & 0xFFu) << 16) | (((unsigned)q3 & 0xFFu) << 24); }
            st16_wt(xq + (size_t)row * D + 16 * lane, o4);
        }
        if (lane < 32 && (lane & 3) == 0) sar[m + (lane >> 2) * NGW] = mysar;
    }
}
__device__ __forceinline__ void p0_prologue(const Frame& F) {
    LAS float* scr = (LAS float*)(F.lds + F.wave * 16384);
    const int gw = F.vcu * 8 + F.wave, NGW = F.G * 8;
    unsigned char* ws = karg_ws();
    constexpr int I_POOL = (512 / 64) * (D / 32);
    constexpr int I_EOUT = (512 / 64) * (D / 32), I_EIN = (D / 64) * (EIN / 32), I_OQKV = (D / 64) * (3 * D / 32), I_OOUT = (D / 64) * (D / 32), I_UP = (D / 64) * (2 * FF / 32), I_DN = (FF / 64) * (D / 32);
    constexpr int NITEMS = 2 * (I_EOUT + I_EIN + I_OOUT) + 4 * I_DN;
    const int role = gw & 3, ridx = gw >> 2;
    constexpr int NSTR = 4 * N_STRIPS + 2 * Q_STRIPS;
    if (role == 0 && ridx < 2 * I_POOL) { const int it = ridx; const int l = it / I_POOL, r = it % I_POOL; const int nblk = D / 32, kb = r / nblk, nb = r % nblk;
        pool_item(karg_in<4>() + (size_t)l * D * D, karg_in<7>() + (size_t)l * 4 * 128 * 128, karg_in<8>() + (size_t)l * 512, (bf16_t*)(ws + WS_W_EOUT + l * SZ_SQ), 512 + 64 * kb, 32 * nb, scr, F.lane); }
    else if (role == 1 || (role == 2 && ridx < NSTR - 512)) { const int sidx = role == 1 ? ridx : 512 + ridx;
        if (sidx < 4 * N_STRIPS) up_strip(sidx / N_STRIPS, sidx % N_STRIPS, ws, scr, F.lane); else { const int q = sidx - 4 * N_STRIPS; qkv_strip(q / Q_STRIPS, q % Q_STRIPS, ws, scr, F.lane); } }
    else if (role >= 2) {
      const int NPL = 512 + (512 - (NSTR - 512));
      int it = role == 3 ? ridx : 512 + ridx - (NSTR - 512);
      TrDesc dA, dB; f32x4 vA[8], vB[8]; float gA[8], gB[8];
      if (it < NITEMS) { tr_decode(it, dA, ws); tr_load(dA, vA, gA, F.lane); }
      while (it < NITEMS) {
          const int itB = it + NPL;
          if (itB < NITEMS) { tr_decode(itB, dB, ws); tr_load(dB, vB, gB, F.lane); }
          tr_store(dA, vA, gA, scr, F.lane);
          if (itB >= NITEMS) break;
          const int itA = itB + NPL;
          if (itA < NITEMS) { tr_decode(itA, dA, ws); tr_load(dA, vA, gA, F.lane); }
          tr_store(dB, vB, gB, scr, F.lane);
          it = itA;
      } }
    const float* x = karg_in<0>();
    bf16_t* xb = (bf16_t*)(ws + WS_XB); float* ssp = (float*)(ws + WS_SSP);
    const bool is_strip = (role == 1) || (role == 2 && ridx < NSTR - 512);
    if (!is_strip) {
        const int NRW = NGW - NSTR;
        const int rw = role == 0 ? ridx : (role == 3 ? 512 + ridx : 1024 + ridx - (NSTR - 512));
        for (int m = rw; m < M; m += 2 * NRW) {
            const int m2 = m + NRW; const bool two = m2 < M;
            const GAS f32x4* xr = (const GAS f32x4*)(x + (size_t)m * D) + F.lane; const GAS f32x4* xr2 = (const GAS f32x4*)(x + (size_t)(two ? m2 : m) * D) + F.lane; f32x4 v[4], v2[4]; float s = 0.f, s2 = 0.f;
#pragma unroll
            for (int j = 0; j < 4; ++j) { v[j] = xr[64 * j]; v2[j] = xr2[64 * j]; }
#pragma unroll
            for (int j = 0; j < 4; ++j) { s += (v[j][0] * v[j][0] + v[j][1] * v[j][1]) + (v[j][2] * v[j][2] + v[j][3] * v[j][3]); s2 += (v2[j][0] * v2[j][0] + v2[j][1] * v2[j][1]) + (v2[j][2] * v2[j][2] + v2[j][3] * v2[j][3]); }
            s = wave_sum(s); s2 = wave_sum(s2);
            GAS unsigned long long* o8 = (GAS unsigned long long*)(xb + (size_t)m * D) + F.lane;
#pragma unroll
            for (int j = 0; j < 4; ++j) o8[64 * j] = (unsigned long long)pk2(v[j][0], v[j][1]) | ((unsigned long long)pk2(v[j][2], v[j][3]) << 32);
            if (F.lane < 16) ssp[(size_t)m * 16 + F.lane] = (F.lane == 0) ? s : 0.f;
            if (two) { GAS unsigned long long* o82 = (GAS unsigned long long*)(xb + (size_t)m2 * D) + F.lane;
#pragma unroll
                for (int j = 0; j < 4; ++j) o82[64 * j] = (unsigned long long)pk2(v2[j][0], v2[j][1]) | ((unsigned long long)pk2(v2[j][2], v2[j][3]) << 32);
                if (F.lane < 16) ssp[(size_t)m2 * 16 + F.lane] = (F.lane == 0) ? s2 : 0.f; }
        }
    }
}

__device__ __forceinline__ int crow(int r, int hi) { return (r & 3) + 8 * (r >> 2) + 4 * hi; }
typedef short v4i16_t __attribute__((ext_vector_type(4)));
__device__ __forceinline__ s16x4 vtr(const LAS char* p) { return __builtin_bit_cast(s16x4, __builtin_amdgcn_ds_read_tr16_b64_v4i16((LAS v4i16_t*)p)); }
typedef __bf16 bf16x2_t __attribute__((ext_vector_type(2)));
__device__ __forceinline__ unsigned cvtpk(float lo, float hi) { f32x2 v = {lo, hi}; bf16x2_t b = __builtin_convertvector(v, bf16x2_t); return __builtin_bit_cast(unsigned, b); }
__device__ __forceinline__ float swap_other(float v, int hi) {
    auto rr = __builtin_amdgcn_permlane32_swap(__float_as_uint(v), __float_as_uint(v), false, false);
    return __uint_as_float(hi ? rr[0] : rr[1]);
}
__device__ __forceinline__ unsigned swap_or(unsigned v) { auto rr = __builtin_amdgcn_permlane32_swap(v, v, false, false); return rr[0] | rr[1]; }

__device__ __forceinline__ void load_kfrag(bf16x8 (&kf)[8], const bf16_t* Kt  , int pitch, int r32, int hi) {
    const unsigned koff = (unsigned)(r32 * pitch + 8 * hi) * 2u;
#pragma unroll
    for (int d0 = 0; d0 < 4; ++d0)
#pragma unroll
        for (int h = 0; h < 2; ++h) kf[2 * d0 + h] = *(const bf16x8*)((const char*)Kt + (size_t)(32 * h * pitch + 16 * d0) * 2 + koff);
}
__device__ __forceinline__ void qkt(f32x16& p0, f32x16& p1, const bf16x8 (&kf)[8], const bf16x8 (&qr)[4]) {
    p0 = f32x16{}; p1 = f32x16{};
#pragma unroll
    for (int d0 = 0; d0 < 4; ++d0) {
        p0 = __builtin_amdgcn_mfma_f32_32x32x16_bf16(kf[2 * d0], qr[d0], p0, 0, 0, 0);
        p1 = __builtin_amdgcn_mfma_f32_32x32x16_bf16(kf[2 * d0 + 1], qr[d0], p1, 0, 0, 0);
    }
}
__device__ __forceinline__ void load_vtile(u32x4 (&vr)[8], const bf16_t* Vt  , int pitch, int lane) {
    const unsigned voff = (unsigned)((lane >> 2) * pitch + (lane & 3) * 8) * 2u;
#pragma unroll
    for (int p = 0; p < 8; ++p) vr[p] = *(const u32x4*)((const char*)Vt + (size_t)(16 * (p & 3) * pitch + (p >> 2) * 32) * 2 + voff);
}
__device__ __forceinline__ void glds16_s(const void* sbase  , unsigned voff  , unsigned lds_dst  ) {
    unsigned keep;
    asm volatile("s_nop 4\n\ts_mov_b32 %0, m0\n\ts_mov_b32 m0, %3\n\ts_nop 0\n\tglobal_load_lds_dwordx4 %1, %2\n\ts_mov_b32 m0, %0" : "=&s"(keep) : "v"(voff), "s"(sbase), "s"(lds_dst) : "memory");
}
__device__ __forceinline__ void dma_vtile(const bf16_t* Vt  , int pitch, int lane, LAS char* vslot  ) {
    const unsigned voff = (unsigned)((lane >> 2) * pitch + (lane & 3) * 8) * 2u;
    const unsigned l0 = (unsigned)(size_t)vslot;
#pragma unroll
    for (int p = 0; p < 8; ++p) glds16_s((const char*)Vt + (size_t)(16 * (p & 3) * pitch + (p >> 2) * 32) * 2, voff, l0 + p * 1024);
}
__device__ __forceinline__ void store_vtile(const u32x4 (&vr)[8], LAS char* vslot, int lane) {
#pragma unroll
    for (int p = 0; p < 8; ++p) *(LAS u32x4*)(vslot + p * 1024 + lane * 16) = vr[p];
}
__device__ __forceinline__ void pv_load(bf16x8 (&vf)[8], const LAS char* vp0) {
#pragma unroll
    for (int ks = 0; ks < 4; ++ks)
#pragma unroll
        for (int d0 = 0; d0 < 2; ++d0) {
            const s16x4 lo = vtr(vp0 + d0 * 4096 + ks * 1024), hi4 = vtr(vp0 + d0 * 4096 + ks * 1024 + 512);
            vf[2 * ks + d0] = (bf16x8){lo[0], lo[1], lo[2], lo[3], hi4[0], hi4[1], hi4[2], hi4[3]};
        }
}
__device__ __forceinline__ void pv_mma(f32x16 (&o)[2], const bf16x8 (&vf)[8], const f32x16& P0, const f32x16& P1) {
    u32x4 pw[4];
#pragma unroll
    for (int i = 0; i < 4; ++i) { pw[0][i] = cvtpk(P0[2 * i], P0[2 * i + 1]); pw[1][i] = cvtpk(P0[8 + 2 * i], P0[9 + 2 * i]); pw[2][i] = cvtpk(P1[2 * i], P1[2 * i + 1]); pw[3][i] = cvtpk(P1[8 + 2 * i], P1[9 + 2 * i]); }
#pragma unroll
    for (int ks = 0; ks < 4; ++ks)
#pragma unroll
        for (int d0 = 0; d0 < 2; ++d0) o[d0] = __builtin_amdgcn_mfma_f32_32x32x16_bf16(__builtin_bit_cast(bf16x8, pw[ks]), vf[2 * ks + d0], o[d0], 0, 0, 0);
}
__device__ __forceinline__ void pv(f32x16 (&o)[2], const LAS char* vp0, const f32x16& P0, const f32x16& P1) {
    bf16x8 vf[8]; pv_load(vf, vp0); __builtin_amdgcn_sched_barrier(0); pv_mma(o, vf, P0, P1);
}
__device__ __forceinline__ void store_o(const f32x16 (&o)[2], const float (&rsc)[16], LAS char* stgc, bf16_t* Ow  , int pitch, int lane, int r32, int hi) {
    LAS bf16_t* stg = (LAS bf16_t*)stgc;
#pragma unroll
    for (int r = 0; r < 16; ++r) { const int orow = crow(r, hi);
#pragma unroll
        for (int d0 = 0; d0 < 2; ++d0) stg[orow * 64 + d0 * 32 + r32] = (bf16_t)f2bf(o[d0][r] * rsc[r]); }
    LDS_WAIT();
#pragma unroll
    for (int i = 0; i < 4; ++i) { const int row = i * 8 + (lane >> 3), ch = lane & 7; const u32x4 v = *(const LAS u32x4*)(stg + row * 64 + ch * 8); st16_wt(Ow + (size_t)row * pitch + ch * 8, v); }
    LDS_WAIT();
}

constexpr int WL_V = 0, WL_O = 0, WL_F = 16384, WL_STRIDE = 16640;
static_assert(8 * WL_STRIDE <= LDSCTL_OFF, "per-wave attention scratch");

template <bool diag> __device__ __forceinline__ void sb_tile_math_t(f32x16& z0, f32x16& z1, float& carry, int s0, int tq, int hi) {
        f32x16 q0, q1;
#pragma unroll
        for (int r = 0; r < 16; ++r) {
            const int kv = s0 + crow(r, hi);
            { float q = __builtin_amdgcn_rcpf(1.0f + __builtin_amdgcn_exp2f(z0[r])); if (diag && !(kv < tq)) q = 1.f; q0[r] = q; }
            { float q = __builtin_amdgcn_rcpf(1.0f + __builtin_amdgcn_exp2f(z1[r])); if (diag && !(kv + 32 < tq)) q = 1.f; q1[r] = q; }
        }
        float own[8], oth[8], S[8];
#pragma unroll
        for (int G = 0; G < 4; ++G) { own[G] = (q0[4 * G] * q0[4 * G + 1]) * (q0[4 * G + 2] * q0[4 * G + 3]); own[4 + G] = (q1[4 * G] * q1[4 * G + 1]) * (q1[4 * G + 2] * q1[4 * G + 3]); }
#pragma unroll
        for (int i = 0; i < 8; ++i) { const auto rr = __builtin_amdgcn_permlane32_swap(__float_as_uint(own[i]), __float_as_uint(own[i]), false, false);
            own[i] = __uint_as_float(rr[0]) * __uint_as_float(rr[1]); oth[i] = __uint_as_float(rr[1]); }
        float run = 1.f;
#pragma unroll
        for (int i = 7; i >= 0; --i) { S[i] = run; run *= own[i]; }
#pragma unroll
        for (int i = 0; i < 8; ++i) {
            float after = carry * S[i] * (hi == 0 ? oth[i] : 1.f);
#pragma unroll
            for (int e = 3; e >= 0; --e) {
                const int r = 4 * (i & 3) + e;
                if (i < 4) { const float nx = after * q0[r]; z0[r] = after - nx; after = nx; }
                else       { const float nx = after * q1[r]; z1[r] = after - nx; after = nx; }
            }
        }
        carry *= run;
}
__device__ __forceinline__ void sb_tile_math(f32x16& z0, f32x16& z1, float& carry, bool diag, int s0, int tq, int hi) {
    if (diag) sb_tile_math_t<true>(z0, z1, carry, s0, tq, hi); else sb_tile_math_t<false>(z0, z1, carry, s0, tq, hi);
}

__device__ __forceinline__ void sb_unit(int b, int h, int qb, const bf16_t* Q, const bf16_t* K, const bf16_t* V, bf16_t* O, LAS char* wl, int lane, bool dry) {
    const int r32 = lane & 31, hi = lane >> 5; const int t0 = qb * 32; const size_t rowbase = (size_t)b * T;
    const bf16_t* Qw = Q + (rowbase + t0) * D + h * 64; const bf16_t* Kh = K + rowbase * D + h * 64; const bf16_t* Vh = V + rowbase * D + h * 64;
    bf16x8 qr[4];
#pragma unroll
    for (int d0 = 0; d0 < 4; ++d0) qr[d0] = *(const bf16x8*)(Qw + (size_t)r32 * D + 16 * d0 + 8 * hi);
    f32x16 o[2]; o[0] = f32x16{}; o[1] = f32x16{};
    float carry = 1.f; const int tq = t0 + r32; const int jd = t0 >> 6;
    const LAS char* vp0 = wl + WL_V + ((lane >> 4) & 1) * 32 + (lane & 3) * 8 + (4 * hi + ((lane & 15) >> 2)) * 64;
    bf16x8 kf[8];
    load_kfrag(kf, Kh + (size_t)jd * 64 * D, D, r32, hi);
    dma_vtile(Vh + (size_t)jd * 64 * D, D, lane, wl + WL_V);
    int slot = 0;
    for (int j = jd; j >= 0; --j) {
        const int s0 = j * 64;
        VM_WAIT();
        if (j > 0) dma_vtile(Vh + (size_t)(s0 - 64) * D, D, lane, wl + WL_V + (slot ^ 8192));
        f32x16 z0, z1; qkt(z0, z1, kf, qr);
        if (j > 0) load_kfrag(kf, Kh + (size_t)(s0 - 64) * D, D, r32, hi);
        sb_tile_math(z0, z1, carry, j == jd, s0, tq, hi);
        pv(o, vp0 + slot, z0, z1);
        if (__builtin_amdgcn_ballot_w64(carry != 0.f) == 0ull) break;
        LDS_WAIT();
        slot ^= 8192;
    }
    VM_WAIT(); LDS_WAIT();
    float one[16];
#pragma unroll
    for (int r = 0; r < 16; ++r) one[r] = 1.f;
    if (!dry) store_o(o, one, wl + WL_O, O + (rowbase + t0) * D + h * 64, D, lane, r32, hi);
}

constexpr int SL_SLOT = 32768, SL_HEAD = 16384, SL_VOFF = 8192, SL_O = 98304, SL_FLAG = 131072;
static_assert(SL_FLAG + 64 <= LDSCTL_OFF, "stick-breaking LDS");
__device__ __forceinline__ void sb_prefetch(bf16x8 (&qr)[4], int b, int hp, int u, const bf16_t* Q, const bf16_t* K, const bf16_t* V, LAS char* L, int wid, int lane) {
    const int r32 = lane & 31, hi = lane >> 5; const int hh = wid >> 2, qw = wid & 3, h = 2 * hp + hh;
    const int t0 = 128 * u + 32 * qw; const size_t rowbase = (size_t)b * T; const int jtop = 2 * u + 1;
    const bf16_t* Qw = Q + (rowbase + t0) * D + h * 64; const bf16_t* Kh = K + rowbase * D + h * 64; const bf16_t* Vh = V + rowbase * D + h * 64;
    const unsigned kvoff = (unsigned)lane * 2048u, vvoff = (unsigned)((lane >> 2) * D + (lane & 3) * 8) * 2u;
    const int pa = 2 * qw, pb = 2 * qw + 1;
    const bf16_t* Kwa = Kh + pa * 8; const bf16_t* Kwb = Kh + pb * 8;
    const bf16_t* Vwa = Vh + (size_t)(16 * (pa & 3)) * D + (pa >> 2) * 32; const bf16_t* Vwb = Vh + (size_t)(16 * (pb & 3)) * D + (pb >> 2) * 32;
    const unsigned hbase = (unsigned)(size_t)L + hh * SL_HEAD;
    const unsigned kda = hbase + pa * 1024u, kdb = hbase + pb * 1024u, vda = hbase + SL_VOFF + pa * 1024u, vdb = hbase + SL_VOFF + pb * 1024u;
#pragma unroll
    for (int k = 0; k < 2; ++k) { const size_t ro_ = (size_t)(jtop - k) * 64 * D; const unsigned so_ = (unsigned)(k * SL_SLOT);
        glds16_s(Kwa + ro_, kvoff, kda + so_); glds16_s(Kwb + ro_, kvoff, kdb + so_); glds16_s(Vwa + ro_, vvoff, vda + so_); glds16_s(Vwb + ro_, vvoff, vdb + so_); }
#pragma unroll
    for (int d0 = 0; d0 < 4; ++d0) qr[d0] = *(const bf16x8*)(Qw + (size_t)r32 * D + 16 * d0 + 8 * hi);
}
__device__ __forceinline__ void sb_block_unit(bf16x8 (&qr)[4], int b, int hp  , int u  , int nb, int nhp, int nu, const bf16_t* Q, const bf16_t* K, const bf16_t* V, bf16_t* O, LAS char* L, int wid, int lane) {
    const int r32 = lane & 31, hi = lane >> 5; const int hh = wid >> 2, qw = wid & 3, h = 2 * hp + hh;
    const int t0 = 128 * u + 32 * qw; const size_t rowbase = (size_t)b * T; const int jtop = 2 * u + 1, jdw = t0 >> 6; const int tq = t0 + r32;
    const bf16_t* Kh = K + rowbase * D + h * 64; const bf16_t* Vh = V + rowbase * D + h * 64;
    const unsigned kvoff = (unsigned)lane * 2048u;
    const unsigned vvoff = (unsigned)((lane >> 2) * D + (lane & 3) * 8) * 2u;
    const int pa = 2 * qw, pb = 2 * qw + 1;
    const bf16_t* Kwa = Kh + pa * 8; const bf16_t* Kwb = Kh + pb * 8;
    const bf16_t* Vwa = Vh + (size_t)(16 * (pa & 3)) * D + (pa >> 2) * 32; const bf16_t* Vwb = Vh + (size_t)(16 * (pb & 3)) * D + (pb >> 2) * 32;
    const unsigned hbase = (unsigned)(size_t)L + hh * SL_HEAD;
    const unsigned kda = hbase + pa * 1024u, kdb = hbase + pb * 1024u, vda = hbase + SL_VOFF + pa * 1024u, vdb = hbase + SL_VOFF + pb * 1024u;
    const LAS char* kp0 = L + hh * SL_HEAD + hi * 1024 + r32 * 16;
    const LAS char* vp0 = L + hh * SL_HEAD + SL_VOFF + ((lane >> 4) & 1) * 32 + (lane & 3) * 8 + (4 * hi + ((lane & 15) >> 2)) * 64;
    LAS unsigned* flags = (LAS unsigned*)(L + SL_FLAG);
    if (lane == 0) flags[wid] = 0u;
#define SB_STAGE(j_, so_) do { const size_t ro_ = (size_t)(j_) * 64 * D; glds16_s(Kwa + ro_, kvoff, kda + (so_)); glds16_s(Kwb + ro_, kvoff, kdb + (so_)); glds16_s(Vwa + ro_, vvoff, vda + (so_)); glds16_s(Vwb + ro_, vvoff, vdb + (so_)); } while (0)
    f32x16 o[2]; o[0] = f32x16{}; o[1] = f32x16{};
    float carry = 1.f; bool gone = false;
    asm volatile("s_waitcnt vmcnt(0) lgkmcnt(0)\n\ts_barrier" ::: "memory");
    int sc = 0, sn = SL_SLOT, sn2 = 2 * SL_SLOT;
    for (int j = jtop; j >= 0; --j) {
        if (j >= 2) SB_STAGE(j - 2, (unsigned)sn2);
        if (j <= jdw && !gone) {
            bf16x8 kf[8];
#pragma unroll
            for (int d0 = 0; d0 < 4; ++d0) { kf[2 * d0] = *(const LAS bf16x8*)(kp0 + sc + d0 * 2048); kf[2 * d0 + 1] = *(const LAS bf16x8*)(kp0 + sc + d0 * 2048 + 512); }
            __builtin_amdgcn_sched_barrier(0);
            f32x16 z0, z1; qkt(z0, z1, kf, qr);
            bf16x8 vf[8]; pv_load(vf, vp0 + sc);
            __builtin_amdgcn_sched_barrier(0);
            sb_tile_math(z0, z1, carry, j == jdw, j * 64, tq, hi);
            pv_mma(o, vf, z0, z1);
            if (__builtin_amdgcn_ballot_w64(carry != 0.f) == 0ull) { gone = true; if (lane == 0) flags[wid] = 1u; }
        }
        if (j >= 2) asm volatile("s_waitcnt vmcnt(4) lgkmcnt(0)\n\ts_barrier" ::: "memory");
        else asm volatile("s_waitcnt vmcnt(0) lgkmcnt(0)\n\ts_barrier" ::: "memory");
        { const u32x4 f0 = *(const LAS u32x4*)flags, f1 = *(const LAS u32x4*)(flags + 4);
          if ((f0[0] & f0[1] & f0[2] & f0[3] & f1[0] & f1[1] & f1[2] & f1[3]) != 0u) break; }
        { const int t_ = sc; sc = sn; sn = sn2; sn2 = t_; }
    }
#undef SB_STAGE
    asm volatile("s_waitcnt vmcnt(0)" ::: "memory");
    if (nb >= 0) sb_prefetch(qr, nb, nhp, nu, Q, K, V, L, wid, lane);
    float one[16];
#pragma unroll
    for (int r = 0; r < 16; ++r) one[r] = 1.f;
    store_o(o, one, L + SL_O + wid * 4096, O + (rowbase + t0) * D + h * 64, D, lane, r32, hi);
    asm volatile("s_waitcnt lgkmcnt(0)\n\ts_barrier" ::: "memory");
}

__device__ __forceinline__ void dsa_unit(int b, int h, int qb, const bf16_t* Q, const bf16_t* K, const bf16_t* V, const unsigned long long* mask, bf16_t* O, LAS char* wl, int lane) {
    const int r32 = lane & 31, hi = lane >> 5; const int t0 = qb * 32; const size_t rowbase = (size_t)b * T; const int kvh = h >> 2;
    const bf16_t* Qw = Q + (rowbase + t0) * 512 + h * 64; const bf16_t* Kh = K + rowbase * 128 + kvh * 64; const bf16_t* Vh = V + rowbase * 128 + kvh * 64;
    const unsigned long long* mrow = mask + (rowbase + t0 + r32) * 64;
    bf16x8 qr[4];
#pragma unroll
    for (int d0 = 0; d0 < 4; ++d0) qr[d0] = *(const bf16x8*)(Qw + (size_t)r32 * 512 + 16 * d0 + 8 * hi);
    f32x16 o[2]; o[0] = f32x16{}; o[1] = f32x16{};
    float mrun = -1e30f, lsum = 0.f; const int jd = t0 >> 6;
    LAS float* wsf = (LAS float*)(wl + WL_F);
    const LAS char* vp0 = wl + WL_V + ((lane >> 4) & 1) * 32 + (lane & 3) * 8 + (4 * hi + ((lane & 15) >> 2)) * 64;
    bf16x8 kf[8];
    load_kfrag(kf, Kh, 128, r32, hi);
    dma_vtile(Vh, 128, lane, wl + WL_V);
    unsigned long long mw = mrow[0]; int slot = 0;
    for (int j = 0; j <= jd; ++j) {
        const int s0 = j * 64;
        VM_WAIT();
        if (j < jd) dma_vtile(Vh + (size_t)(s0 + 64) * 128, 128, lane, wl + WL_V + (slot ^ 8192));
        f32x16 p0, p1; qkt(p0, p1, kf, qr);
        if (j < jd) load_kfrag(kf, Kh + (size_t)(s0 + 64) * 128, 128, r32, hi);
        const unsigned long long mwn = (j < jd) ? mrow[j + 1] : 0ull;
        const unsigned mlo = (unsigned)mw >> (4 * hi), mhi = (unsigned)(mw >> 32) >> (4 * hi);
        float rm = -INFINITY;
#pragma unroll
        for (int r = 0; r < 16; ++r) { const int bit = (r & 3) + 8 * (r >> 2);
            if (!((mlo >> bit) & 1u)) p0[r] = -INFINITY; if (!((mhi >> bit) & 1u)) p1[r] = -INFINITY;
            rm = __builtin_fmaxf(rm, __builtin_fmaxf(p0[r], p1[r])); }
        rm = __builtin_fmaxf(rm, swap_other(rm, hi));
        const float mnew = __builtin_fmaxf(mrun, rm);
        const float alpha = __builtin_amdgcn_exp2f(mrun - mnew);
        float ps = 0.f;
#pragma unroll
        for (int r = 0; r < 16; ++r) { p0[r] = __builtin_amdgcn_exp2f(p0[r] - mnew); p1[r] = __builtin_amdgcn_exp2f(p1[r] - mnew); ps += p0[r] + p1[r]; }
        lsum = lsum * alpha + ps;
        if (__builtin_amdgcn_ballot_w64(mnew > mrun) != 0ull) {
            if (hi == 0) wsf[r32] = alpha;
            LDS_WAIT();
#pragma unroll
            for (int r = 0; r < 16; ++r) { const float f = wsf[crow(r, hi)]; o[0][r] *= f; o[1][r] *= f; }
        }
        mrun = mnew;
        LDS_WAIT();
        pv(o, vp0 + slot, p0, p1);
        LDS_WAIT();
        slot ^= 8192; mw = mwn;
    }
    VM_WAIT();
    lsum += swap_other(lsum, hi);
    if (hi == 0) wsf[32 + r32] = lsum;
    LDS_WAIT();
    float rli[16];
#pragma unroll
    for (int r = 0; r < 16; ++r) rli[r] = 1.0f / wsf[32 + crow(r, hi)];
    store_o(o, rli, wl + WL_O, O + (rowbase + t0) * D + h * 64, D, lane, r32, hi);
}

constexpr int IL_QF = 103424;
constexpr int DL_K = 0, DL_V = 24576, DL_O = 49152, DL_F = 81920, DL_T = 83968;
constexpr float DSA_THR = 8.0f;
__device__ __forceinline__ float max3f(float a, float b, float c) { float r; asm("v_max3_f32 %0, %1, %2, %3" : "=v"(r) : "v"(a), "v"(b), "v"(c)); return r; }
__device__ __forceinline__ float dsa_cinit(unsigned word, int bit, unsigned negm) {
    unsigned m, c; asm("v_bfe_i32 %0, %1, %2, 1" : "=v"(m) : "v"(word), "n"(bit)); asm("v_bfi_b32 %0, %1, %2, %3" : "=v"(c) : "v"(m), "v"(negm), "v"(0xFF800000u)); return __uint_as_float(c);
}
__device__ __forceinline__ void dsa_qk(f32x16& p0, f32x16& p1, const LAS char* kp, const bf16x8 (&qr)[4], unsigned long long mw, int hi, float mref, const LAS char* tbl) {
    bf16x8 kf[8];
#pragma unroll
    for (int d0 = 0; d0 < 4; ++d0) { kf[2 * d0] = *(const LAS bf16x8*)(kp + d0 * 2048); kf[2 * d0 + 1] = *(const LAS bf16x8*)(kp + d0 * 2048 + 512); }
    const unsigned mlo = (unsigned)mw >> (4 * hi), mhi = (unsigned)(mw >> 32) >> (4 * hi), negm = __float_as_uint(-mref);
    if (tbl) {
#pragma unroll
        for (int i = 0; i < 4; ++i) { const u32x4 a = *(const LAS u32x4*)(tbl + ((mlo >> (8 * i)) & 15u) * 16u), b = *(const LAS u32x4*)(tbl + ((mhi >> (8 * i)) & 15u) * 16u);
#pragma unroll
            for (int e = 0; e < 4; ++e) { p0[4 * i + e] = __uint_as_float(a[e]); p1[4 * i + e] = __uint_as_float(b[e]); } }
        __builtin_amdgcn_sched_barrier(0);
    } else {
        __builtin_amdgcn_sched_barrier(0);
#pragma unroll
        for (int r = 0; r < 16; ++r) { p0[r] = dsa_cinit(mlo, (r & 3) + 8 * (r >> 2), negm); p1[r] = dsa_cinit(mhi, (r & 3) + 8 * (r >> 2), negm); }
        __builtin_amdgcn_sched_barrier(0);
    }
#pragma unroll
    for (int d0 = 0; d0 < 4; ++d0) {
        p0 = __builtin_amdgcn_mfma_f32_32x32x16_bf16(kf[2 * d0], qr[d0], p0, 0, 0, 0);
        p1 = __builtin_amdgcn_mfma_f32_32x32x16_bf16(kf[2 * d0 + 1], qr[d0], p1, 0, 0, 0);
    }
}
__device__ __forceinline__ void dsa_step(f32x16& c0, f32x16& c1, f32x16& n0, f32x16& n1, const bool have_n, const LAS char* kpn, const LAS char* vpc, const bf16x8 (&qr)[4], unsigned long long mwn,
                                         f32x16 (&o)[2], float& mref, float& lsum, LAS float* wsf, int r32, int hi, const bool fixed, const LAS char* tblp) {
    if (have_n) dsa_qk(n0, n1, kpn, qr, mwn, hi, mref, fixed ? tblp : (const LAS char*)nullptr);
    bf16x8 vf[8]; pv_load(vf, vpc);
    __builtin_amdgcn_sched_barrier(0);
    bool resc = false; float rm = 0.f;
    if (!fixed) {
        rm = __builtin_fmaxf(c0[0], c1[0]);
#pragma unroll
        for (int r = 1; r < 16; ++r) rm = max3f(rm, c0[r], c1[r]);
        rm = __builtin_fmaxf(rm, swap_other(rm, hi));
        resc = __builtin_amdgcn_ballot_w64(rm > DSA_THR) != 0ull;
    }
    if (resc) { const float dl = __builtin_fmaxf(rm, 0.f); mref += dl; const float f = __builtin_amdgcn_exp2f(-dl); lsum *= f; if (hi == 0) wsf[r32] = f;
#pragma unroll
        for (int r = 0; r < 16; ++r) { c0[r] -= dl; c1[r] -= dl; }
        if (have_n) {
#pragma unroll
            for (int r = 0; r < 16; ++r) { n0[r] -= dl; n1[r] -= dl; } } }
    f32x2 ps2 = {0.f, 0.f};
#pragma unroll
    for (int r = 0; r < 16; r += 2) { c0[r] = __builtin_amdgcn_exp2f(c0[r]); c0[r + 1] = __builtin_amdgcn_exp2f(c0[r + 1]); c1[r] = __builtin_amdgcn_exp2f(c1[r]); c1[r + 1] = __builtin_amdgcn_exp2f(c1[r + 1]);
        ps2 += (f32x2){c0[r], c0[r + 1]}; ps2 += (f32x2){c1[r], c1[r + 1]}; }
    lsum += ps2[0] + ps2[1];
    if (resc) { LDS_WAIT();
#pragma unroll
        for (int r = 0; r < 16; ++r) { const float f = wsf[crow(r, hi)]; o[0][r] *= f; o[1][r] *= f; } }
    pv_mma(o, vf, c0, c1);
    asm volatile("s_waitcnt vmcnt(0) lgkmcnt(0)\n\ts_barrier" ::: "memory");
}
__device__ __forceinline__ void dsa_block_unit(int b, int g, int m  , const bf16_t* Q, const bf16_t* K, const bf16_t* V, const unsigned long long* mask, bf16_t* O, LAS char* L, int wid, int lane, float sbound  ) {
    const int r32 = lane & 31, hi = lane >> 5; const int h = 4 * g + (wid & 3), t0 = 64 * m + 32 * (wid >> 2); const size_t rowbase = (size_t)b * T; const int jd = m;
    const bf16_t* Qw = Q + (rowbase + t0) * 512 + h * 64; const bf16_t* Kg = K + rowbase * 128 + g * 64; const bf16_t* Vg = V + rowbase * 128 + g * 64;
    const unsigned long long* mrow = mask + (rowbase + t0 + r32) * 64;
    bf16x8 qr[4];
#pragma unroll
    for (int d0 = 0; d0 < 4; ++d0) qr[d0] = *(const bf16x8*)(Qw + (size_t)r32 * 512 + 16 * d0 + 8 * hi);
    f32x16 o[2]; o[0] = f32x16{}; o[1] = f32x16{};
    const bool fixed = sbound > 0.f;
    float mref = fixed ? sbound : 0.f, lsum = 0.f;
    LAS float* wsf = (LAS float*)(L + DL_F + wid * 256);
    const unsigned kvoff = (unsigned)lane * 256u;
    const unsigned vvoff = (unsigned)((lane >> 2) * 128 + (lane & 3) * 8) * 2u;
    const bf16_t* Kw = Kg + wid * 8; const bf16_t* Vw = Vg + (size_t)(16 * (wid & 3)) * 128 + (wid >> 2) * 32;
    const unsigned kdst = (unsigned)(size_t)(L + DL_K) + wid * 1024u, vdst = (unsigned)(size_t)(L + DL_V) + wid * 1024u;
    const LAS char* kp0 = L + DL_K + hi * 1024 + r32 * 16;
    const LAS char* vp0 = L + DL_V + ((lane >> 4) & 1) * 32 + (lane & 3) * 8 + (4 * hi + ((lane & 15) >> 2)) * 64;
    glds16_s(Kw, kvoff, kdst); glds16_s(Vw, vvoff, vdst);
    if (jd >= 1) { glds16_s(Kw + (size_t)64 * 128, kvoff, kdst + 8192); glds16_s(Vw + (size_t)64 * 128, vvoff, vdst + 8192); }
    unsigned long long mwn = mrow[0];
    unsigned long long mwn2 = (jd >= 1) ? mrow[1] : 0ull;
    asm volatile("s_waitcnt vmcnt(0) lgkmcnt(0)\n\ts_barrier" ::: "memory");
    const LAS char* tblp = L + DL_T;
    f32x16 pa0, pa1, pb0, pb1; dsa_qk(pa0, pa1, kp0, qr, mwn, hi, mref, fixed ? tblp : (const LAS char*)nullptr);
    mwn = mwn2;
    int sc = 0, sn = 8192, sn2 = 16384;
    for (int j = 0; j <= jd; j += 2) {
        if (j + 2 <= jd) { glds16_s(Kw + (size_t)(j + 2) * 64 * 128, kvoff, kdst + sn2); glds16_s(Vw + (size_t)(j + 2) * 64 * 128, vvoff, vdst + sn2); mwn2 = mrow[j + 2]; }
        dsa_step(pa0, pa1, pb0, pb1, j < jd, kp0 + sn, vp0 + sc, qr, mwn, o, mref, lsum, wsf, r32, hi, fixed, tblp);
        if (j == jd) break;
        { const int t_ = sc; sc = sn; sn = sn2; sn2 = t_; } mwn = mwn2;
        if (j + 3 <= jd) { glds16_s(Kw + (size_t)(j + 3) * 64 * 128, kvoff, kdst + sn2); glds16_s(Vw + (size_t)(j + 3) * 64 * 128, vvoff, vdst + sn2); mwn2 = mrow[j + 3]; }
        dsa_step(pb0, pb1, pa0, pa1, j + 1 < jd, kp0 + sn, vp0 + sc, qr, mwn, o, mref, lsum, wsf, r32, hi, fixed, tblp);
        { const int t_ = sc; sc = sn; sn = sn2; sn2 = t_; } mwn = mwn2;
    }
    lsum += swap_other(lsum, hi);
    if (hi == 0) wsf[32 + r32] = lsum;
    LDS_WAIT();
    float rli[16];
#pragma unroll
    for (int r = 0; r < 16; ++r) rli[r] = 1.0f / wsf[32 + crow(r, hi)];
    store_o(o, rli, L + DL_O + wid * 4096, O + (rowbase + t0) * D + h * 64, D, lane, r32, hi);
}

__device__ __forceinline__ unsigned fkey(float v) { unsigned u = __float_as_uint(v); if (u == 0x80000000u) u = 0u; return (u & 0x80000000u) ? ~u : (u | 0x80000000u); }
__device__ __forceinline__ void idx_scores_half(f32x16& sc, const bf16_t* KIt  , const LAS char* QF, const f32x4& w, int r32, int hi) {
    bf16x8 kf[4];
#pragma unroll
    for (int d0 = 0; d0 < 4; ++d0) kf[d0] = *(const bf16x8*)(KIt + (size_t)r32 * 64 + 16 * d0 + 8 * hi);
    sc = f32x16{};
#pragma unroll
    for (int h = 0; h < 4; ++h) { f32x16 p = f32x16{};
#pragma unroll
        for (int d0 = 0; d0 < 4; ++d0) p = __builtin_amdgcn_mfma_f32_32x32x16_bf16(kf[d0], *(const LAS bf16x8*)(QF + ((h * 4 + d0) * 2 + hi) * 512 + r32 * 16), p, 0, 0, 0);
#pragma unroll
        for (int r = 0; r < 16; ++r) sc[r] = fmaf(w[h], __builtin_fmaxf(p[r], 0.f), sc[r]); }
}
__device__ __forceinline__ void idx_unit(int b, int qb, const bf16_t* QI, const bf16_t* KI, const float* WI, unsigned long long* mask, LAS unsigned* hist, int tid) {
    const int lane = tid & 63, wid = __builtin_amdgcn_readfirstlane(tid >> 6), r32 = lane & 31, hi = lane >> 5;
    const int t0 = qb * 32, jd = t0 >> 6, jtop = 4 * (t0 >> 8) + 3; const size_t rowbase = (size_t)b * T; const int tq = t0 + r32;
    const size_t row = rowbase + tq;
    const LAS char* qf = (const LAS char*)hist + IL_QF;
    const f32x4 w = *(const f32x4*)(WI + row * 4);
    const bf16_t* KIb = KI + rowbase * 64;
    unsigned base = 0u, need = 256u, sthr = 4095u, jt = 0u; bool done = (t0 < 256);
    if (t0 >= 256) {
        for (int i = tid; i < 2 * 32 * 65; i += 512) hist[i] = 0u;
        __syncthreads();
        for (int stage = 0; stage < 8; ++stage) {
            LAS unsigned* HB = hist + (stage & 1) * (32 * 65);
            const int shift = stage < 5 ? 26 - 6 * stage : (stage == 5 ? 0 : (stage == 6 ? 6 : 0));
            const unsigned bmask = (stage == 5) ? 3u : 63u;
            const unsigned xmask = stage == 0 ? 0u : (stage < 6 ? (0xFFFFFFFFu << (shift + (stage == 5 ? 2 : 6))) : 0xFFFFFFFFu);
            for (int j = wid; j <= jd; j += 8) {
                const bool diag = (j == jd);
#pragma unroll 1
                for (int p = 0; p < 2; ++p) {
                    f32x16 sc; idx_scores_half(sc, KIb + (size_t)(j * 64 + 32 * p) * 64, qf, w, r32, hi);
#pragma unroll
                    for (int r = 0; r < 16; ++r) {
                        const int s = j * 64 + 32 * p + crow(r, hi); const unsigned key = fkey(sc[r]);
                        bool in = !done && (!diag || s <= tq) && (((key ^ base) & xmask) == 0u);
                        if (stage == 7) in = in && ((unsigned)j == jt);
                        const unsigned src = stage < 6 ? key : (unsigned)s;
                        const unsigned bin = (src >> shift) & bmask;
                        if (in) __hip_atomic_fetch_add(&HB[r32 * 65 + bin], 1u, __ATOMIC_RELAXED, __HIP_MEMORY_SCOPE_WORKGROUP);
                    }
                }
            }
            __syncthreads();
            if (!done) {
                const int nb = (stage == 5) ? 4 : 64; const bool desc = stage < 6;
                unsigned cum = 0u, tb = 0u, before = 0u, ctb = 0u; bool found = false;
                for (int i = 0; i < nb; ++i) { const int bidx = desc ? nb - 1 - i : i; const unsigned c = HB[r32 * 65 + bidx];
                    if (!found && cum + c >= need) { found = true; tb = (unsigned)bidx; before = cum; ctb = c; }
                    cum += c; }
                if (!found) { tb = desc ? 0u : (unsigned)(nb - 1); before = 0u; ctb = need; }
                need -= before;
                if (stage < 6) { base |= tb << shift; if (need == ctb) done = true; }
                else if (stage == 6) { jt = tb; }
                else { sthr = 64u * jt + tb; done = true; }
            }
            { LAS unsigned* HN = hist + ((stage + 1) & 1) * (32 * 65); for (int i = tid; i < 32 * 65; i += 512) HN[i] = 0u; }
            __syncthreads();
            if (__builtin_amdgcn_ballot_w64(!done) == 0ull) break;
        }
    }
    for (int j = wid; j <= jtop; j += 8) {
        unsigned lo = 0u, hw = 0u;
        if (j <= jd) {
            const bool diag = (j == jd);
#pragma unroll 1
            for (int p = 0; p < 2; ++p) {
                f32x16 sc; idx_scores_half(sc, KIb + (size_t)(j * 64 + 32 * p) * 64, qf, w, r32, hi);
                unsigned bits = 0u;
#pragma unroll
                for (int r = 0; r < 16; ++r) {
                    const int s = j * 64 + 32 * p + crow(r, hi); const unsigned key = fkey(sc[r]);
                    const bool sel = (!diag || s <= tq) && (key > base || (key == base && (unsigned)s <= sthr));
                    if (sel) bits |= 1u << crow(r, 0);
                }
                bits <<= 4 * hi;
                if (p) hw = bits; else lo = bits;
            }
        }
        lo = swap_or(lo); hw = swap_or(hw);
        if (hi == 0) mask[row * 64 + j] = (unsigned long long)lo | ((unsigned long long)hw << 32);
    }
    __syncthreads();
}

constexpr int IDX_CAP = 192, ZBIN = 160, NBINS = 320, HSTR = 321;
constexpr int IL_CNT = 0, IL_TABN = 128, IL_TABNEED = 256, IL_TABBIN = 384, IL_CAND = 512, IL_HIST = IL_CAND, IL_MASK = IL_CAND + 32 * IDX_CAP * 8, IL_Z = IL_MASK + 32 * 64 * 8, IL_END = IL_Z + 32 * 64 * 8;
static_assert(IL_QF >= IL_END && IL_QF + 16384 <= RING_BYTES, "indexer LDS (qf)");
static_assert(32 * HSTR * 4 <= 32 * IDX_CAP * 8 && (32 * HSTR * 4) % 16 == 0 && IL_END <= RING_BYTES, "indexer LDS");
__device__ __forceinline__ unsigned fkey2(float v) { const unsigned u = __float_as_uint(v + 0.0f); return u ^ ((unsigned)((int)u >> 31) | 0x80000000u); }
__device__ __forceinline__ int imed3(int a, int lo, int hi) { const int x = a > hi ? hi : a; return x < lo ? lo : x; }
__device__ __forceinline__ int ibin_u(unsigned u) {
    const int a = (int)u >> 20;
    return imed3(-953 - a, 0, 159) + imed3(a - 936, 0, 158) + imed3((int)u, -160, 1) + 160;
}
__device__ __forceinline__ int ibin_u_m160(unsigned u) {
    const int a = (int)u >> 20;
    return imed3(-953 - a, 0, 159) + imed3(a - 936, 0, 158) + imed3((int)u, -160, 1);
}
__device__ __forceinline__ unsigned keylo(int b) {
    return b <= 0 ? 0u : (b <= 159 ? (unsigned)(b + 952) << 20 : (b == 160 ? 0x80000000u : (b == 161 ? 0x80000001u : (b <= 319 ? (0x80000000u | ((unsigned)(b + 775) << 20)) : 0xFFFFFFFFu))));
}
__device__ __forceinline__ float relu_i(float p) { const int i = __float_as_int(p); return __int_as_float(i > 0 ? i : 0); }
__device__ __forceinline__ void shl_ge(unsigned& acc, unsigned key, unsigned thr) { asm("v_cmp_ge_u32 vcc, %1, %2\n\tv_addc_co_u32 %0, vcc, %0, %0, vcc" : "+v"(acc) : "v"(key), "v"(thr) : "vcc"); }
__device__ __forceinline__ unsigned spread4(unsigned x) { return (x & 0xFu) | ((x & 0xF0u) << 4) | ((x & 0xF00u) << 8) | ((x & 0xF000u) << 12); }
__device__ __forceinline__ void idx_loadk(bf16x8 (&kf)[4], const bf16_t* KIt, int r32, int hi) {
#pragma unroll
    for (int d0 = 0; d0 < 4; ++d0) kf[d0] = *(const bf16x8*)(KIt + (size_t)r32 * 64 + 16 * d0 + 8 * hi);
}
__device__ __forceinline__ void idx_scores_k(f32x16& sc, const bf16x8 (&kf)[4], const bf16x8 (&qf)[16], const f32x4& w) {
    f32x16 p0 = f32x16{}, p1 = f32x16{};
#pragma unroll
    for (int d0 = 0; d0 < 4; ++d0) p0 = __builtin_amdgcn_mfma_f32_32x32x16_bf16(kf[d0], qf[d0], p0, 0, 0, 0);
#pragma unroll
    for (int d0 = 0; d0 < 4; ++d0) p1 = __builtin_amdgcn_mfma_f32_32x32x16_bf16(kf[d0], qf[4 + d0], p1, 0, 0, 0);
#pragma unroll
    for (int r = 0; r < 16; ++r) sc[r] = w[0] * relu_i(p0[r]);
    p0 = f32x16{};
#pragma unroll
    for (int d0 = 0; d0 < 4; ++d0) p0 = __builtin_amdgcn_mfma_f32_32x32x16_bf16(kf[d0], qf[8 + d0], p0, 0, 0, 0);
#pragma unroll
    for (int r = 0; r < 16; ++r) sc[r] = fmaf(w[1], relu_i(p1[r]), sc[r]);
    p1 = f32x16{};
#pragma unroll
    for (int d0 = 0; d0 < 4; ++d0) p1 = __builtin_amdgcn_mfma_f32_32x32x16_bf16(kf[d0], qf[12 + d0], p1, 0, 0, 0);
#pragma unroll
    for (int r = 0; r < 16; ++r) sc[r] = fmaf(w[2], relu_i(p0[r]), sc[r]);
#pragma unroll
    for (int r = 0; r < 16; ++r) sc[r] = fmaf(w[3], relu_i(p1[r]), sc[r]);
}
template <int PASS, bool DIAG> __device__ __forceinline__ void idx_half(unsigned& bits, unsigned& ebits, const f32x16& sc, int sbase, int tq, int r32, int hi, unsigned khi, unsigned klo, bool cand, LAS unsigned char* L) {
    bits = 0u; ebits = 0u;
    const int d = tq - sbase - 4 * hi;
    if (PASS == 1) {
        LAS unsigned* H = (LAS unsigned*)(L + IL_HIST) + r32 * HSTR + 160;
#pragma unroll
        for (int r = 0; r < 16; ++r) { int b = ibin_u_m160(__float_as_uint(sc[r] + 0.0f)); asm("" : "+v"(b));
            if (!DIAG || crow(r, 0) <= d) __hip_atomic_fetch_add(H + b, 1u, __ATOMIC_RELAXED, __HIP_MEMORY_SCOPE_WORKGROUP); }
    } else {
        unsigned hb = 0u, lb = 0u;
#pragma unroll
        for (int r = 15; r >= 0; --r) { const unsigned key = fkey2(sc[r]); shl_ge(hb, key, khi); shl_ge(lb, key, klo); }
        bits = spread4(hb); ebits = spread4(lb & ~hb);
        if (DIAG) { const unsigned vm = d < 0 ? 0u : (d >= 31 ? 0xFFFFFFFFu : ((2u << d) - 1u)); bits &= vm; ebits &= vm; }
        if (cand && ebits != 0u) {
            unsigned slot = __hip_atomic_fetch_add((LAS unsigned*)(L + IL_CNT) + r32, (unsigned)__builtin_popcount(ebits), __ATOMIC_RELAXED, __HIP_MEMORY_SCOPE_WORKGROUP);
#pragma unroll
            for (int r = 0; r < 16; ++r) if ((ebits >> crow(r, 0)) & 1u) { const int s = sbase + crow(r, hi);
                if (slot < (unsigned)IDX_CAP) ((LAS unsigned long long*)(L + IL_CAND))[r32 * IDX_CAP + slot] = ((unsigned long long)fkey2(sc[r]) << 16) | (unsigned long long)(0xFFFFu - (unsigned)s);
                ++slot; }
        }
        bits <<= 4 * hi; ebits <<= 4 * hi;
    }
}
template <int PASS> __device__ __forceinline__ void idx_pass(const bf16_t* KIb, const bf16x8 (&qf)[16], const f32x4& w, int jd, int tq, int wid, int r32, int hi, unsigned khi, unsigned klo, bool cand, LAS unsigned char* L) {
    bf16x8 kA[4], kB[4];
    int j = wid;
    if (j <= jd) idx_loadk(kA, KIb + (size_t)(j * 64) * 64, r32, hi);
    for (; j <= jd; j += 8) {
        const bool diag = (j == jd);
        idx_loadk(kB, KIb + (size_t)(j * 64 + 32) * 64, r32, hi);
        f32x16 sc; idx_scores_k(sc, kA, qf, w);
        unsigned lo, elo, hw, ehw;
        if (diag) idx_half<PASS, true>(lo, elo, sc, j * 64, tq, r32, hi, khi, klo, cand, L); else idx_half<PASS, false>(lo, elo, sc, j * 64, tq, r32, hi, khi, klo, cand, L);
        if (j + 8 <= jd) idx_loadk(kA, KIb + (size_t)((j + 8) * 64) * 64, r32, hi);
        idx_scores_k(sc, kB, qf, w);
        if (diag) idx_half<PASS, true>(hw, ehw, sc, j * 64 + 32, tq, r32, hi, khi, klo, cand, L); else idx_half<PASS, false>(hw, ehw, sc, j * 64 + 32, tq, r32, hi, khi, klo, cand, L);
        if (PASS == 2) { lo = swap_or(lo); hw = swap_or(hw); elo = swap_or(elo); ehw = swap_or(ehw);
            if (hi == 0) { ((LAS unsigned long long*)(L + IL_MASK))[r32 * 64 + j] = (unsigned long long)lo | ((unsigned long long)hw << 32);
                           ((LAS unsigned long long*)(L + IL_Z))[r32 * 64 + j] = (unsigned long long)elo | ((unsigned long long)ehw << 32); } }
    }
}
template <int NC> __device__ __forceinline__ void idx_rank(LAS unsigned long long* cc, int n, unsigned nd, int lane, LAS unsigned* mrow) {
    const int n8 = (n + 7) & ~7;
    if (lane < 7 && n + lane < n8) { unsigned z; asm volatile("v_mov_b32 %0, 0" : "=v"(z)); ((LAS unsigned*)cc)[2 * (n + lane)] = z; ((LAS unsigned*)cc)[2 * (n + lane) + 1] = z; }
    LDS_WAIT();
    unsigned long long me[NC]; unsigned rank[NC];
#pragma unroll
    for (int k = 0; k < NC; ++k) { me[k] = (lane + 64 * k < n) ? cc[lane + 64 * k] : ~0ull; rank[k] = 0u; }
#pragma unroll 2
    for (int c2 = 0; c2 < n8; c2 += 8) {
        unsigned long long a[8];
#pragma unroll
        for (int i = 0; i < 8; ++i) a[i] = cc[c2 + i];
#pragma unroll
        for (int i = 0; i < 8; ++i)
#pragma unroll
            for (int k = 0; k < NC; ++k) rank[k] += (a[i] > me[k]) ? 1u : 0u;
    }
#pragma unroll
    for (int k = 0; k < NC; ++k) if (lane + 64 * k < n && rank[k] < nd) { const unsigned sI = 0xFFFFu - (unsigned)(me[k] & 0xFFFFull);
        __hip_atomic_fetch_or(mrow + (sI >> 5), 1u << (sI & 31), __ATOMIC_RELAXED, __HIP_MEMORY_SCOPE_WORKGROUP); }
}
__device__ __forceinline__ bool idx_unit_fast(int b, int qb, const bf16_t* QI, const bf16_t* KI, const float* WI, unsigned long long* mask, LAS unsigned char* L, int tid) {
    asm volatile("" : "+v"(tid));
    const int lane0 = tid & 63, wid = __builtin_amdgcn_readfirstlane(tid >> 6), r32 = lane0 & 31, hi = lane0 >> 5;
    const int t0 = qb * 32, jd = t0 >> 6, jtop = 4 * (t0 >> 8) + 3; const size_t rowbase = (size_t)b * T; const int tq = t0 + r32;
    if (t0 < 256) {
        const int r = tid >> 4, j = tid & 15, t = t0 + r;
        if (j <= jtop) { const int n = t - 64 * j + 1; const unsigned long long m = n >= 64 ? ~0ull : (n <= 0 ? 0ull : ((1ull << n) - 1ull)); mask[(rowbase + t) * 64 + j] = m; }
        return false;
    }
    const size_t row = rowbase + tq;
    if (tid < 32) ((LAS unsigned*)(L + IL_CNT))[tid] = 0u;
    for (int i = tid; i < 32 * HSTR * 4 / 16; i += 512) ((LAS u32x4*)(L + IL_HIST))[i] = (u32x4){0u, 0u, 0u, 0u};
    for (int i = tid; i < (IL_END - IL_MASK) / 16; i += 512) ((LAS u32x4*)(L + IL_MASK))[i] = (u32x4){0u, 0u, 0u, 0u};
    { const int rr = tid & 31;
#pragma unroll
      for (int k = 0; k < 2; ++k) { const int p = (tid >> 5) + 16 * k; *(LAS u32x4*)(L + IL_QF + p * 512 + rr * 16) = *(const u32x4*)(QI + (rowbase + t0 + rr) * 256 + 8 * p); } }
    const f32x4 w = *(const f32x4*)(WI + row * 4);
    const bf16_t* KIb = KI + rowbase * 64;
    __syncthreads();
    bf16x8 qf[16];
#pragma unroll
    for (int i = 0; i < 16; ++i) qf[i] = *(const LAS bf16x8*)(L + IL_QF + (i * 2 + hi) * 512 + r32 * 16);
    idx_pass<1>(KIb, qf, w, jd, tq, wid, r32, hi, 0u, 0u, false, L);
    __syncthreads();
    { const int sr = tid >> 4, sq = tid & 15, b0 = NBINS - 20 - 20 * sq; const LAS unsigned* H = (const LAS unsigned*)(L + IL_HIST) + sr * HSTR + b0;
      unsigned c[20], ssum = 0u;
#pragma unroll
      for (int i = 0; i < 20; ++i) { c[i] = H[i]; ssum += c[i]; }
      unsigned incl = ssum;
#pragma unroll
      for (int o = 1; o < 16; o <<= 1) { const unsigned v = shfl_up_u(incl, o, lane0); if (sq >= o) incl += v; }
      unsigned cum = incl - ssum;
      if (cum < 256u && incl >= 256u) { bool found = false; int tb = 0; unsigned nd = 0u, ct = 0u;
#pragma unroll
          for (int i = 19; i >= 0; --i) { if (!found && cum + c[i] >= 256u) { found = true; tb = b0 + i; nd = 256u - cum; ct = c[i]; } cum += c[i]; }
          ((LAS unsigned*)(L + IL_TABN))[sr] = ct; ((LAS unsigned*)(L + IL_TABNEED))[sr] = nd; ((LAS unsigned*)(L + IL_TABBIN))[sr] = (unsigned)tb; } }
    __syncthreads();
    const int thrbin = (int)((const LAS unsigned*)(L + IL_TABBIN))[r32]; const unsigned cthr = ((const LAS unsigned*)(L + IL_TABN))[r32];
    const bool ovf = (thrbin != ZBIN) && cthr > (unsigned)IDX_CAP;
    if (__builtin_amdgcn_ballot_w64(ovf) != 0ull) return true;
    idx_pass<2>(KIb, qf, w, jd, tq, wid, r32, hi, keylo(thrbin + 1), keylo(thrbin), thrbin != ZBIN, L);
    __syncthreads();
    asm volatile("" : "+v"(tid));
    const int lane = tid & 63;
    for (int q = 0; q < 4; ++q) { const int r = 4 * wid + q; const int n = (int)((const LAS unsigned*)(L + IL_TABN))[r]; const unsigned nd = ((const LAS unsigned*)(L + IL_TABNEED))[r];
        const bool zrow = ((const LAS unsigned*)(L + IL_TABBIN))[r] == (unsigned)ZBIN;
        if (zrow) {
            const unsigned long long z = ((const LAS unsigned long long*)(L + IL_Z))[r * 64 + lane]; const unsigned c = (unsigned)__builtin_popcountll(z);
            unsigned incl = c;
#pragma unroll
            for (int o = 1; o < 64; o <<= 1) { const unsigned v = shfl_up_u(incl, o, lane); if (lane >= o) incl += v; }
            const unsigned excl = incl - c; unsigned long long take = 0ull;
            if (incl <= nd) take = z;
            else if (excl < nd) { unsigned long long zz = z; for (unsigned k = nd - excl; k > 0u; --k) { const unsigned long long low = zz & (0ull - zz); take |= low; zz ^= low; } }
            if (take) ((LAS unsigned long long*)(L + IL_MASK))[r * 64 + lane] |= take;
        } else {
            LAS unsigned long long* cc = (LAS unsigned long long*)(L + IL_CAND) + r * IDX_CAP;
            const int nc = (n + 63) >> 6;
            if (nc <= 1) idx_rank<1>(cc, n, nd, lane, (LAS unsigned*)(L + IL_MASK) + r * 128); else if (nc == 2) idx_rank<2>(cc, n, nd, lane, (LAS unsigned*)(L + IL_MASK) + r * 128); else idx_rank<3>(cc, n, nd, lane, (LAS unsigned*)(L + IL_MASK) + r * 128);
        }
    }
    __syncthreads();
    { const int r = tid >> 4; const LAS unsigned long long* ML = (const LAS unsigned long long*)(L + IL_MASK) + r * 64; unsigned long long* MG = mask + (rowbase + t0 + r) * 64;
      for (int j = 2 * (tid & 15); j <= jtop; j += 32) { const unsigned long long w0 = ML[j], w1 = ML[j + 1]; st16_wt(MG + j, (u32x4){(unsigned)w0, (unsigned)(w0 >> 32), (unsigned)w1, (unsigned)(w1 >> 32)}); } }
    __syncthreads();
    return false;
}

template <int WND> __device__ __forceinline__ void pool_ld(u32x4 (&v)[WND], const bf16_t* U, int row, int ch8) {
    const int t = row % T;
#pragma unroll
    for (int i = 0; i < WND; ++i) { const int ri = i <= t ? i : t; v[i] = *(const u32x4*)(U + (size_t)(row - ri) * 512 + ch8 * 8); }
}
template <int WND> __device__ __forceinline__ void pool_st(const u32x4 (&v)[WND], __amdgpu_buffer_rsrc_t mix, int row, int ch8) {
    const int t = row % T; const int cnt = (t + 1 < WND) ? t + 1 : WND;
    float acc[8], cur[8];
#pragma unroll
    for (int e = 0; e < 8; ++e) acc[e] = 0.f;
#pragma unroll
    for (int i = 0; i < WND; ++i) {
#pragma unroll
        for (int e = 0; e < 4; ++e) { const unsigned wv = (i < cnt) ? v[i][e] : 0u; const float a = __uint_as_float(wv << 16), bq = __uint_as_float(wv & 0xFFFF0000u); acc[2 * e] += a; acc[2 * e + 1] += bq; if (i == 0) { cur[2 * e] = a; cur[2 * e + 1] = bq; } } }
    const float fc = (float)cnt; u32x4 o;
#pragma unroll
    for (int e = 0; e < 4; ++e) o[e] = pk2(acc[2 * e] / fc - cur[2 * e], acc[2 * e + 1] / fc - cur[2 * e + 1]);
    __builtin_amdgcn_raw_buffer_store_b128(o, mix, (row * D + 512 + ch8 * 8) * 2, 0, 16);
}
__device__ __forceinline__ void pool_rows(int row0, int nrows, const bf16_t* U, bf16_t* MIX, int tid) {
    const __amdgpu_buffer_rsrc_t mix = __builtin_amdgcn_make_buffer_rsrc((void*)MIX, 0, 0x7FFFFFFF, 0x00020000);
    const int w = __builtin_amdgcn_readfirstlane(tid >> 6), lane = tid & 63, chl = lane & 15;
    const int r0 = row0 + 8 * w + (lane >> 4), r1 = r0 + 4;
    u32x4 A[16], B[8], C[4], E2[2];
    pool_ld<16>(A, U, r0, 48 + chl);
    pool_ld<8>(B, U, r0, 32 + chl);  pool_st<16>(A, mix, r0, 48 + chl);
    pool_ld<4>(C, U, r0, 16 + chl);  pool_st<8>(B, mix, r0, 32 + chl);
    pool_ld<2>(E2, U, r0, chl);      pool_st<4>(C, mix, r0, 16 + chl);
    pool_ld<16>(A, U, r1, 48 + chl); pool_st<2>(E2, mix, r0, chl);
    pool_ld<8>(B, U, r1, 32 + chl);  pool_st<16>(A, mix, r1, 48 + chl);
    pool_ld<4>(C, U, r1, 16 + chl);  pool_st<8>(B, mix, r1, 32 + chl);
    pool_ld<2>(E2, U, r1, chl);      pool_st<4>(C, mix, r1, 16 + chl);
    pool_st<2>(E2, mix, r1, chl);
}

#ifndef REP_E2
#define REP_E2 1
#endif
#ifndef REP_E3
#define REP_E3 1
#endif
#ifndef REP_O2
#define REP_O2 1
#endif
#ifndef REP_G1
#define REP_G1 1
#endif
#ifndef REP_UP
#define REP_UP 1
#endif
#ifndef REP_DN
#define REP_DN 1
#endif
#ifndef REP_PRO
#define REP_PRO 1
#endif
#ifndef REP_QKV
#define REP_QKV 1
#endif
#ifndef REP_OUT
#define REP_OUT 1
#endif
extern __shared__ __attribute__((aligned(16))) unsigned char lds_raw[];
#define LDS0 ((LAS unsigned char*)lds_raw)
__device__ __forceinline__ void grid_barrier(int wave_s) {
    XcdBarrier b; b.bar = (unsigned*)(karg_ws() + WS_CTL) + 4096; b.x = xb_xcc_id(); b.st = (volatile LAS unsigned*)(LDS0 + MISC_OFF) + 8;
    xcd_barrier_impl(b, wave_s == 0 && lane_id() == 0);
}
__device__ __forceinline__ Frame make_frame(int wave_s) {
    Frame F; F.lds = LDS0; { int t_ = wave_s * 64 + lane_id(); asm volatile("" : "+v"(t_)); F.tid = t_; } F.lane = F.tid & 63; F.wave = wave_s;
    F.G = gridDim.x; { const int bx = blockIdx.x; F.vcu = (F.G % 8 == 0) ? (bx % 8) * (F.G / 8) + bx / 8 : bx; }
    return F;
}
template <class Epi> __device__ __forceinline__ void run_gemm(const pg8::Gemm& g, const Epi& E, int wave_s) {
    pg8::StaticOrder S; S.init(M, g.N, (int)gridDim.x, (int)blockIdx.x);
    pg8::gemm_phase<Epi, true, true>(LDS0, (LAS float*)(LDS0 + TAB_OFF), g, S, E, wave_s);
}

__global__ void __launch_bounds__(512, 2) trunk_fwd(Args args) {
    const int wave_s = __builtin_amdgcn_readfirstlane((int)threadIdx.x >> 6);
    {
        LAS unsigned char* lds0 = LDS0;
        for (int u = wave_s * 64 + lane_id(); u < (LDS_BYTES - LDSCTL_OFF) / 4; u += 512) ((LAS unsigned*)(lds0 + LDSCTL_OFF))[u] = 0u;
        __syncthreads();
        if (wave_s == 0 && lane_id() == 0) (void)xb_add(&((unsigned*)(karg_ws() + WS_CTL) + 4096)[XB_XCNT(xb_xcc_id())], 1u);
    }
#ifndef NO_PRO
    for (int rep_ = 0; rep_ < REP_PRO; ++rep_) { const Frame F = make_frame(wave_s); p0_prologue(F); }
#endif
    grid_barrier(wave_s);

#pragma unroll 1
    for (int layer = 0; layer < DEPTH; ++layer) {
        const int li = layer >> 1;
        if ((layer & 1) == 0) {
            { unsigned char* ws = karg_ws();
              pg8::Gemm g{(const bf16_t*)(ws + WS_XB), (const bf16_t*)(ws + WS_W_EIN + li * SZ_EIN), EIN, D, D, (const float*)(ws + WS_SSP)};
              pg8::EpiEvenIn E{ws, karg_in<5>() + li * 64, karg_in<6>() + li * 64};
#ifndef NO_G1
              for (int rep_ = 0; rep_ < REP_G1; ++rep_) run_gemm(g, E, wave_s);
#endif
            }
            grid_barrier(wave_s);
            { const Frame F = make_frame(wave_s); unsigned char* ws = karg_ws(); const int c = F.vcu; const int b = c >> 6, i = c & 63;
#ifndef NO_IDX
              if (F.G == 256) for (int rep_ = 0; rep_ < REP_E2; ++rep_) {
#pragma unroll 1
                  for (int k = 0; k < 2; ++k) { const int qb = k ? i : 127 - i;
                      const bool fb = idx_unit_fast(b, qb, (const bf16_t*)(ws + WS_EQI), (const bf16_t*)(ws + WS_EKI), (const float*)(ws + WS_EWI), (unsigned long long*)(ws + WS_MASK), F.lds, F.tid);
                      if (fb) idx_unit(b, qb, (const bf16_t*)(ws + WS_EQI), (const bf16_t*)(ws + WS_EKI), (const float*)(ws + WS_EWI), (unsigned long long*)(ws + WS_MASK), (LAS unsigned*)F.lds, F.tid); }
              }
#endif
#ifndef NO_POOL
              for (int r0 = c * 64; r0 < M; r0 += F.G * 64) pool_rows(r0, 64, (const bf16_t*)(ws + WS_EU), (bf16_t*)(ws + WS_EMIX), F.tid);
#endif
            }
            grid_barrier(wave_s);
#ifndef NO_DSA
            { const Frame F = make_frame(wave_s); unsigned char* ws = karg_ws(); LAS char* wl = (LAS char*)(F.lds + F.wave * WL_STRIDE); const int gw = F.vcu * 8 + F.wave, NGW = F.G * 8;
              float sbound;
              { float mq = __builtin_fabsf((karg_in<5>() + li * 64)[F.lane]), mk = __builtin_fabsf((karg_in<6>() + li * 64)[F.lane]);
#pragma unroll
                for (int o_ = 1; o_ < 64; o_ <<= 1) { mq = __builtin_fmaxf(mq, shfl_xor_f(mq, o_, F.lane)); mk = __builtin_fmaxf(mk, shfl_xor_f(mk, o_, F.lane)); }
                sbound = 64.0f * C2 * 1.03f * mq * mk; if (!(sbound <= 24.0f)) sbound = -1.0f; }
              if (F.tid < 64) { const int n_ = F.tid >> 2, e_ = F.tid & 3;
                  ((LAS unsigned*)(F.lds + DL_T))[F.tid] = ((n_ >> e_) & 1) ? __float_as_uint(-sbound) : 0xFF800000u; }
              __syncthreads();
              for (int rep_ = 0; rep_ < REP_E3; ++rep_)
              for (int p = F.vcu; p < NB * 2 * 32; p += F.G) { const int bg = p >> 5, mm = p & 31;
                  dsa_block_unit(bg >> 1, bg & 1, 63 - mm, (const bf16_t*)(ws + WS_EQ), (const bf16_t*)(ws + WS_EK), (const bf16_t*)(ws + WS_EV), (const unsigned long long*)(ws + WS_MASK), (bf16_t*)(ws + WS_EMIX), (LAS char*)F.lds, F.wave, F.lane, sbound);
                  dsa_block_unit(bg >> 1, bg & 1, mm, (const bf16_t*)(ws + WS_EQ), (const bf16_t*)(ws + WS_EK), (const bf16_t*)(ws + WS_EV), (const unsigned long long*)(ws + WS_MASK), (bf16_t*)(ws + WS_EMIX), (LAS char*)F.lds, F.wave, F.lane, sbound); } }
#endif
            grid_barrier(wave_s);
            { unsigned char* ws = karg_ws(); float* OUT = karg_out();
              pg8::Gemm g{(const bf16_t*)(ws + WS_EMIX), (const bf16_t*)(ws + WS_W_EOUT + li * SZ_SQ), D, D, D, nullptr};
              pg8::EpiRes E{(layer == 0) ? karg_in<0>() : (const float*)nullptr, (float*)nullptr, ws, false};
#ifndef NO_GRES
              for (int rep_ = 0; rep_ < REP_OUT; ++rep_) { E.dry = rep_ + 1 < REP_OUT; run_gemm(g, E, wave_s); }
#endif
            }
            grid_barrier(wave_s);
        } else {
            { const Frame F = make_frame(wave_s); quant_rows(karg_ws(), WS_XQ1, WS_SAR1, F.vcu * 8 + F.wave, F.G * 8, F.lane); }
            grid_barrier(wave_s);
            { unsigned char* ws = karg_ws();
              pg8::Gemm g{(const bf16_t*)(ws + WS_XQ1), (const bf16_t*)(ws + WS_W_OQKV + li * SZ_OQKV), 3 * D, D / 2, D / 2, (const float*)(ws + WS_SAR1)};
              pg8::EpiOddQKVq E{(bf16_t*)(ws + WS_OQ), (const float*)(ws + WS_SWQ) + (size_t)li * 3 * D};
#ifndef NO_GQKV
              for (int rep_ = 0; rep_ < REP_QKV; ++rep_) run_gemm(g, E, wave_s);
#endif
            }
            grid_barrier(wave_s);
#ifndef NO_SB
            { const Frame F = make_frame(wave_s); unsigned char* ws = karg_ws(); LAS char* wl = (LAS char*)(F.lds + F.wave * WL_STRIDE); const int gw = F.vcu * 8 + F.wave, NGW = F.G * 8;
              for (int rep_ = 0; rep_ < REP_O2; ++rep_)
              { bf16x8 qr[4]; int u = F.vcu;
                { const int u0 = u < NB * 8 * 32 ? u : 0;
                  sb_prefetch(qr, u0 >> 8, (u0 >> 5) & 7, u0 & 31, (const bf16_t*)(ws + WS_OQ), (const bf16_t*)(ws + WS_OK), (const bf16_t*)(ws + WS_OV), (LAS char*)F.lds, F.wave, F.lane); }
                for (; u < NB * 8 * 32; u += F.G) { const int bh = u >> 5, ub = u & 31; const int un = u + F.G; const bool hn = un < NB * 8 * 32;
                    sb_block_unit(qr, bh >> 3, bh & 7, ub, hn ? (un >> 8) : -1, (un >> 5) & 7, un & 31, (const bf16_t*)(ws + WS_OQ), (const bf16_t*)(ws + WS_OK), (const bf16_t*)(ws + WS_OV), (bf16_t*)(ws + WS_OQ), (LAS char*)F.lds, F.wave, F.lane); } } }
#endif
            grid_barrier(wave_s);
            { unsigned char* ws = karg_ws(); float* OUT = karg_out();
              pg8::Gemm g{(const bf16_t*)(ws + WS_OQ), (const bf16_t*)(ws + WS_W_OOUT + li * SZ_SQ), D, D, D, nullptr};
              pg8::EpiRes E{(const float*)nullptr, (float*)nullptr, ws, false};
#ifndef NO_GRES
              for (int rep_ = 0; rep_ < REP_OUT; ++rep_) { E.dry = rep_ + 1 < REP_OUT; run_gemm(g, E, wave_s); }
#endif
            }
            grid_barrier(wave_s);
        }
        { const Frame F = make_frame(wave_s); quant_rows(karg_ws(), WS_XQ, WS_SAR, F.vcu * 8 + F.wave, F.G * 8, F.lane); }
        grid_barrier(wave_s);
        { unsigned char* ws = karg_ws();
          pg8::Gemm g{(const bf16_t*)(ws + WS_XQ), (const bf16_t*)(ws + WS_W_UP + layer * SZ_UP), 2 * FF, D / 2, D / 2, (const float*)(ws + WS_SAR)};
          pg8::EpiSwiGLUq E{(bf16_t*)(ws + WS_H2), (const float*)(ws + WS_SW) + (size_t)layer * 2 * FF};
#ifndef NO_GUP
          for (int rep_ = 0; rep_ < REP_UP; ++rep_) run_gemm(g, E, wave_s);
#endif
        }
        grid_barrier(wave_s);
        { unsigned char* ws = karg_ws(); float* OUT = karg_out();
          pg8::Gemm g{(const bf16_t*)(ws + WS_H2), (const bf16_t*)(ws + WS_W_DN + layer * SZ_DN), D, FF, FF, nullptr};
          pg8::EpiRes E{(const float*)nullptr, (layer + 1 == DEPTH) ? OUT : (float*)nullptr, ws, false};
#ifndef NO_GRES
          for (int rep_ = 0; rep_ < REP_DN; ++rep_) { E.dry = rep_ + 1 < REP_DN; run_gemm(g, E, wave_s); }
#endif
        }
        if (layer + 1 < DEPTH) grid_barrier(wave_s);
    }
}

extern "C" void kernel_launch(void* const* d_in, const int* in_sizes, int n_in, void* d_out, int out_size, void* d_ws, size_t ws_size, hipStream_t stream) {
    static int grid = 0;
    if (grid == 0) {
        if (n_in != 14 || in_sizes[0] != M * D || out_size != M * D || ws_size < WS_END) { fprintf(stderr, "kernel_launch: unexpected shapes (n_in %d in0 %d out %d ws %zu); nothing launched\n", n_in, n_in > 0 ? in_sizes[0] : -1, out_size, ws_size); grid = -1; return; }
        int dev = 0, cus = 0, per_cu = 0;
        if (hipGetDevice(&dev) != hipSuccess || hipDeviceGetAttribute(&cus, hipDeviceAttributeMultiprocessorCount, dev) != hipSuccess) { grid = -1; return; }
        if (hipFuncSetAttribute((const void*)trunk_fwd, hipFuncAttributeMaxDynamicSharedMemorySize, LDS_BYTES) != hipSuccess) { fprintf(stderr, "kernel_launch: hipFuncSetAttribute failed\n"); grid = -1; return; }
        if (hipOccupancyMaxActiveBlocksPerMultiprocessor(&per_cu, (const void*)trunk_fwd, 512, LDS_BYTES) != hipSuccess || per_cu < 1) fprintf(stderr, "kernel_launch: occupancy query reports %d\n", per_cu);
        (void)hipGetLastError();
        grid = cus;
    }
    if (grid < 0) return;
    if (hipMemsetAsync((char*)d_ws + WS_CTL, 0, CTL_ZERO_BYTES, stream) != hipSuccess) return;
    Args a{};
    for (int i = 0; i < 14; ++i) a.in[i] = (const float*)d_in[i];
    a.out = (float*)d_out; a.ws = (unsigned char*)d_ws;
    hipLaunchKernelGGL(trunk_fwd, dim3(grid), dim3(512), LDS_BYTES, stream, a);
}
```

```cpp
#include <hip/hip_runtime.h>
#include <hip/hip_bf16.h>
#include <cstdio>
#include <cstdint>

#define LAS __attribute__((address_space(3)))
#define GAS __attribute__((address_space(1)))
typedef unsigned short bf16_t;
typedef short bf16x8 __attribute__((ext_vector_type(8)));
typedef short s16x4 __attribute__((ext_vector_type(4)));
typedef float f32x4 __attribute__((ext_vector_type(4)));
typedef float f32x2 __attribute__((ext_vector_type(2)));
typedef float f32x16 __attribute__((ext_vector_type(16)));
typedef unsigned u32x4 __attribute__((ext_vector_type(4)));
typedef unsigned u32x2 __attribute__((ext_vector_type(2)));

__device__ __forceinline__ float sum_rows4(float v) {
    const auto a = __builtin_amdgcn_permlane16_swap(__float_as_uint(v), __float_as_uint(v), false, false); const float s = __uint_as_float(a[0]) + __uint_as_float(a[1]);
    const auto b = __builtin_amdgcn_permlane32_swap(__float_as_uint(s), __float_as_uint(s), false, false); return __uint_as_float(b[0]) + __uint_as_float(b[1]);
}
__device__ __forceinline__ float shfl_xor_f(float v, int mask, int lane) { return __int_as_float(__builtin_amdgcn_ds_bpermute((lane ^ mask) << 2, __float_as_int(v))); }
__device__ __forceinline__ unsigned shfl_up_u(unsigned v, int o, int lane) { return (unsigned)__builtin_amdgcn_ds_bpermute(((lane >= o) ? lane - o : lane) << 2, (int)v); }
__device__ __forceinline__ int lane_id() { int l; asm volatile("v_mbcnt_lo_u32_b32 %0, -1, 0\n\tv_mbcnt_hi_u32_b32 %0, -1, %0" : "=v"(l)); return l; }
constexpr int NB = 4, T = 4096, D = 1024, M = NB * T, FF = 2816, DEPTH = 4;
constexpr int EIN_SRC = 1604, EIN = 1792;
constexpr float EPS = 1e-6f;
constexpr float C2 = 0.125f * 1.4426950408889634f;

constexpr size_t MiB = 1u << 20;
constexpr size_t WS_CTL = 0, CTL_ZERO_BYTES = 65536;
constexpr size_t WS_W = 1 * MiB;
constexpr size_t SZ_EIN = (size_t)EIN * D * 2, SZ_SQ = (size_t)D * D * 2, SZ_OQKV = (size_t)3 * D * D * 2, SZ_UP = (size_t)2 * FF * D * 2, SZ_DN = (size_t)D * FF * 2;
constexpr size_t WS_W_EIN = WS_W;
constexpr size_t WS_W_EOUT = WS_W_EIN + 2 * SZ_EIN;
constexpr size_t WS_W_OQKV = WS_W_EOUT + 2 * SZ_SQ;
constexpr size_t WS_W_OOUT = WS_W_OQKV + 2 * SZ_OQKV;
constexpr size_t WS_W_UP = WS_W_OOUT + 2 * SZ_SQ;
constexpr size_t WS_W_DN = WS_W_UP + 4 * SZ_UP;
constexpr size_t WS_W_END = WS_W_DN + 4 * SZ_DN;
static_assert(WS_W_END == 94 * MiB, "weights");
constexpr size_t WS_XB = 94 * MiB;
constexpr size_t WS_SSP = 126 * MiB;
constexpr size_t WS_MASK = 127 * MiB;
constexpr size_t WS_ACT = 135 * MiB;
constexpr size_t WS_EQ = WS_ACT;
constexpr size_t WS_EK = WS_EQ + (size_t)M * 512 * 2;
constexpr size_t WS_EV = WS_EK + (size_t)M * 128 * 2;
constexpr size_t WS_EQI = WS_EV + (size_t)M * 128 * 2;
constexpr size_t WS_EKI = WS_EQI + (size_t)M * 256 * 2;
constexpr size_t WS_EWI = WS_EKI + (size_t)M * 64 * 2;
constexpr size_t WS_EU = WS_EWI + (size_t)M * 4 * 4;
constexpr size_t WS_EMIX = WS_EU + (size_t)M * 512 * 2;
constexpr size_t WS_OQ = WS_ACT;
constexpr size_t WS_OK = WS_OQ + (size_t)M * D * 2;
constexpr size_t WS_OV = WS_OK + (size_t)M * D * 2;
constexpr size_t WS_H2 = WS_ACT;
constexpr size_t WS_SW = 256 * 1024;
constexpr size_t WS_SWQ = 512 * 1024;
constexpr size_t WS_XQ = 224 * MiB;
constexpr size_t WS_SAR = 240 * MiB;
constexpr size_t WS_XQ1 = 232 * MiB;
constexpr size_t WS_SAR1 = 248 * MiB;
constexpr size_t WS_END = 256 * MiB;
static_assert(WS_OV + (size_t)M * D * 2 <= WS_XQ1 && WS_XQ1 + (size_t)M * D <= WS_SAR1 && WS_SAR1 + (size_t)M * 4 <= WS_END, "ws map (QKV quantisation)");
static_assert(WS_EMIX + (size_t)M * D * 2 <= WS_XQ && WS_OV + (size_t)M * D * 2 <= WS_END && WS_H2 + (size_t)M * FF * 2 <= WS_XQ && WS_XQ + (size_t)M * D <= WS_SAR && WS_SAR + (size_t)M * 4 <= WS_END && WS_SW + 4 * 2 * FF * 4 <= WS_SWQ && WS_SWQ + 2 * 3 * D * 4 <= MiB, "ws map");

constexpr int RING_BYTES = 131072;
constexpr int TAB_OFF = RING_BYTES;
constexpr int LDSCTL_OFF = TAB_OFF + 2048, MISC_OFF = LDSCTL_OFF + 320;
constexpr int LDS_BYTES = 147456;

__device__ __forceinline__ void st16_wt(void* p, u32x4 v) { asm volatile("global_store_dwordx4 %0, %1, off sc1\n\ts_nop 1" :: "v"(p), "v"(v) : "memory"); }
__device__ __forceinline__ void st8_wt(void* p, u32x2 v) { asm volatile("global_store_dwordx2 %0, %1, off sc1\n\ts_nop 1" :: "v"(p), "v"(v) : "memory"); }
namespace pg8 {
constexpr int BM = 256, BK = 64, HALF = 128, HTB = HALF * BK * 2, STAGE_BYTES = 8 * HTB, NXCD = 8, WGM = 8;
__host__ __device__ __forceinline__ int lds_byte(int r, int c) { const int st = (r >> 4) * 2 + (c >> 5), rr = r & 15, cc = c & 31, ob = rr * 64 + cc * 2; return st * 1024 + (ob ^ (((ob >> 9) & 1) << 5)); }
__host__ __device__ __forceinline__ void stage_rc(int b, int& R, int& C) { const int st = b / 1024, sb = b % 1024, swz = sb ^ (((sb >> 9) & 1) << 5); R = (st >> 1) * 16 + swz / 64; C = (st & 1) * 32 + (swz % 64) / 2; }
__host__ __device__ __forceinline__ int perm32(int rho) { const int n = rho >> 4, i = rho & 15; return 8 * (i >> 2) + 4 * n + (i & 3); }

struct Unit { int pm, pn, hs; };
struct Gemm { const bf16_t* A; const bf16_t* Bt; int N, K, lda; const float* ssp; };

struct StaticOrder {
    int nM, nN, nwg, G, c, htail;
    __device__ void init(int M_, int N, int G_, int c_) { nM = M_ / BM; nN = N / BM; nwg = nM * nN; G = G_; c = c_; htail = -1; }
    __device__ bool next(int i, Unit& u) const {
        u.hs = -1; long L = (long)i * G + c;
        if (i == htail) { L = (long)i * G + (c & (G / 2 - 1)); u.hs = c / (G / 2); }
        if (L >= nwg) return false;
        int wgid = (int)L; { const int q = nwg / NXCD, r = nwg % NXCD, xcd = wgid % NXCD, off = wgid / NXCD; wgid = (xcd < r ? xcd * (q + 1) : r * (q + 1) + (xcd - r) * q) + off; }
        const int nig = WGM * nN, gid = wgid / nig, fm = gid * WGM, gsz = (nM - fm) < WGM ? (nM - fm) : WGM;
        u.pm = fm + ((wgid % nig) % gsz); u.pn = (wgid % nig) / gsz; return true;
    }
};

__device__ __forceinline__ unsigned cvt_pk_bf16(float lo, float hi) { unsigned r; asm volatile("v_cvt_pk_bf16_f32 %0, %1, %2" : "=v"(r) : "v"(lo), "v"(hi)); return r; }

typedef f32x4 Acc[2][2][4][2];
typedef int i32x4 __attribute__((ext_vector_type(4)));
typedef i32x4 AccI[2][2][4][2];

struct EpiEvenIn {
    static constexpr bool PERM = true, NEED_RSTD = true, I8 = false; typedef f32x4 AccV;
    unsigned char* ws; const float *qg, *kg;
    __device__ __forceinline__ void operator()(const Acc& acc, const Unit& u, int wr, int wc, int fr, int fq, const LAS float* tab) const {
        const int pn = u.pn;
        bf16_t* const Q = (bf16_t*)(ws + WS_EQ); bf16_t* const K = (bf16_t*)(ws + WS_EK); bf16_t* const V = (bf16_t*)(ws + WS_EV); bf16_t* const QI = (bf16_t*)(ws + WS_EQI);
        bf16_t* const KI = (bf16_t*)(ws + WS_EKI); bf16_t* const U = (bf16_t*)(ws + WS_EU); float* const WI = (float*)(ws + WS_EWI);
        bf16_t* dst; int pitch; int mode = 0;
        if (pn < 2) { dst = Q + (4 * pn + wc) * 64; pitch = 512; mode = 1; }
        else if (pn == 2) { if (wc < 2) { dst = K + wc * 64; pitch = 128; mode = 2; } else { dst = V + (wc - 2) * 64; pitch = 128; } }
        else if (pn == 3) { dst = QI + wc * 64; pitch = 256; }
        else if (pn < 6) { dst = U + (4 * (pn - 4) + wc) * 64; pitch = 512; }
        else { dst = KI; pitch = 64; mode = (wc == 0) ? 0 : (wc == 1 ? 3 : 4); }
        if (mode == 4) return;
        f32x4 gv[2][2];
#pragma unroll
        for (int bj = 0; bj < 2; ++bj)
#pragma unroll
            for (int n = 0; n < 2; ++n) { gv[bj][n] = (f32x4){1.f, 1.f, 1.f, 1.f};
                if (mode == 1) gv[bj][n] = *(const f32x4*)(qg + 32 * bj + 8 * fq + 4 * n);
                if (mode == 2) gv[bj][n] = *(const f32x4*)(kg + 32 * bj + 8 * fq + 4 * n); }
        float rsv[2][4];
#pragma unroll
        for (int ai = 0; ai < 2; ++ai)
#pragma unroll
            for (int m = 0; m < 4; ++m) rsv[ai][m] = tab[ai * HALF + wr * 64 + m * 16 + fr];
#pragma unroll
        for (int ai = 0; ai < 2; ++ai)
#pragma unroll
            for (int m = 0; m < 4; ++m) {
                const int rl = ai * HALF + wr * 64 + m * 16 + fr; const size_t row = (size_t)u.pm * BM + rl; const float rs = rsv[ai][m];
                f32x4 v[2][2]; float ss = 0.f;
#pragma unroll
                for (int bj = 0; bj < 2; ++bj)
#pragma unroll
                    for (int n = 0; n < 2; ++n) { v[bj][n] = acc[ai][bj][m][n] * rs; const f32x4 x = v[bj][n]; ss += (x[0] * x[0] + x[1] * x[1]) + (x[2] * x[2] + x[3] * x[3]); }
                if (mode == 3) { if (fq == 0) *(f32x4*)(WI + row * 4) = v[0][0]; continue; }
                float sc = 1.f;
                if (mode == 1 || mode == 2) { ss = sum_rows4(ss); sc = rsqrtf(ss * (1.0f / 64.0f) + EPS); if (mode == 1) sc *= C2; }
#pragma unroll
                for (int bj = 0; bj < 2; ++bj) { const f32x4 a = v[bj][0] * gv[bj][0] * sc, b = v[bj][1] * gv[bj][1] * sc;
                    u32x4 w; w.x = cvt_pk_bf16(a[0], a[1]); w.y = cvt_pk_bf16(a[2], a[3]); w.z = cvt_pk_bf16(b[0], b[1]); w.w = cvt_pk_bf16(b[2], b[3]);
                    st16_wt(dst + row * pitch + 32 * bj + 8 * fq, w); }
            }
    }
};

struct EpiOddQKV {
    static constexpr bool PERM = true, NEED_RSTD = true, I8 = false; typedef f32x4 AccV;
    bf16_t* QKV;
    __device__ __forceinline__ void operator()(const Acc& acc, const Unit& u, int wr, int wc, int fr, int fq, const LAS float* tab) const {
        const int t = u.pn >> 2; const float sc0 = (t == 0) ? C2 : 1.f;
        bf16_t* base = QKV + (size_t)t * ((size_t)M * D) + (u.pn & 3) * BM + wc * 32 + 8 * fq;
        float rsv[2][4];
#pragma unroll
        for (int ai = 0; ai < 2; ++ai)
#pragma unroll
            for (int m = 0; m < 4; ++m) rsv[ai][m] = tab[ai * HALF + wr * 64 + m * 16 + fr];
#pragma unroll
        for (int ai = 0; ai < 2; ++ai)
#pragma unroll
            for (int m = 0; m < 4; ++m) {
                const int rl = ai * HALF + wr * 64 + m * 16 + fr; const size_t row = (size_t)u.pm * BM + rl; const float rs = rsv[ai][m] * sc0;
#pragma unroll
                for (int bj = 0; bj < 2; ++bj) { const f32x4 a = acc[ai][bj][m][0] * rs, b = acc[ai][bj][m][1] * rs;
                    u32x4 w; w.x = cvt_pk_bf16(a[0], a[1]); w.y = cvt_pk_bf16(a[2], a[3]); w.z = cvt_pk_bf16(b[0], b[1]); w.w = cvt_pk_bf16(b[2], b[3]);
                    st16_wt(base + row * D + bj * HALF, w); }
            }
    }
};

struct EpiOddQKVq {
    static constexpr bool PERM = true, NEED_RSTD = true, I8 = true; typedef i32x4 AccV;
    bf16_t* QKV; const float* sw;
    __device__ __forceinline__ void operator()(const AccI& acc, const Unit& u, int wr, int wc, int fr, int fq, const LAS float* tab) const {
        const int t = u.pn >> 2; const float sc0 = (t == 0) ? C2 : 1.f;
        bf16_t* base = QKV + (size_t)t * ((size_t)M * D) + (u.pn & 3) * BM + wc * 32 + 8 * fq;
        f32x4 sv[2][2];
#pragma unroll
        for (int bj = 0; bj < 2; ++bj)
#pragma unroll
            for (int n = 0; n < 2; ++n) sv[bj][n] = *(const f32x4*)(sw + u.pn * BM + bj * HALF + wc * 32 + 8 * fq + 4 * n) * sc0;
        float rsv[2][4];
#pragma unroll
        for (int ai = 0; ai < 2; ++ai)
#pragma unroll
            for (int m = 0; m < 4; ++m) rsv[ai][m] = tab[ai * HALF + wr * 64 + m * 16 + fr];
#pragma unroll
        for (int ai = 0; ai < 2; ++ai)
#pragma unroll
            for (int m = 0; m < 4; ++m) {
                const int rl = ai * HALF + wr * 64 + m * 16 + fr; const size_t row = (size_t)u.pm * BM + rl; const float rs = rsv[ai][m];
#pragma unroll
                for (int bj = 0; bj < 2; ++bj) {
                    const i32x4 ia = acc[ai][bj][m][0], ib = acc[ai][bj][m][1];
                    const f32x4 a = (f32x4){(float)ia[0], (float)ia[1], (float)ia[2], (float)ia[3]} * (sv[bj][0] * rs), b = (f32x4){(float)ib[0], (float)ib[1], (float)ib[2], (float)ib[3]} * (sv[bj][1] * rs);
                    u32x4 w; w.x = cvt_pk_bf16(a[0], a[1]); w.y = cvt_pk_bf16(a[2], a[3]); w.z = cvt_pk_bf16(b[0], b[1]); w.w = cvt_pk_bf16(b[2], b[3]);
                    st16_wt(base + row * D + bj * HALF, w); }
            }
    }
};

struct EpiSwiGLUq {
    static constexpr bool PERM = true, NEED_RSTD = true, I8 = true; typedef i32x4 AccV;
    bf16_t* H; const float* sw;
    __device__ __forceinline__ void operator()(const AccI& acc, const Unit& u, int wr, int wc, int fr, int fq, const LAS float* tab) const {
        bf16_t* base = H + u.pn * HALF + wc * 32 + 8 * fq;
        f32x4 sg[2], su[2];
#pragma unroll
        for (int n = 0; n < 2; ++n) { sg[n] = *(const f32x4*)(sw + u.pn * BM + wc * 32 + 8 * fq + 4 * n); su[n] = *(const f32x4*)(sw + u.pn * BM + HALF + wc * 32 + 8 * fq + 4 * n); }
        float rsv[2][4];
        const int nai = u.hs >= 0 ? 1 : 2, ro = u.hs > 0 ? HALF : 0;
#pragma unroll
        for (int ai = 0; ai < 2; ++ai)
#pragma unroll
            for (int m = 0; m < 4; ++m) rsv[ai][m] = tab[(ai * HALF + ro + wr * 64 + m * 16 + fr) & 255];
#pragma unroll
        for (int ai = 0; ai < 2; ++ai)
#pragma unroll
            for (int m = 0; m < 4; ++m) if (ai < nai) {
                const int rl = ai * HALF + ro + wr * 64 + m * 16 + fr; const size_t row = (size_t)u.pm * BM + rl; const float rs = rsv[ai][m];
                float o[8];
#pragma unroll
                for (int n = 0; n < 2; ++n)
#pragma unroll
                    for (int e = 0; e < 4; e += 2) {
                        const f32x2 g = (f32x2){(float)acc[ai][0][m][n][e], (float)acc[ai][0][m][n][e + 1]} * ((f32x2){sg[n][e], sg[n][e + 1]} * rs);
                        const f32x2 up = (f32x2){(float)acc[ai][1][m][n][e], (float)acc[ai][1][m][n][e + 1]} * ((f32x2){su[n][e], su[n][e + 1]} * rs);
                        f32x2 d; d.x = __builtin_amdgcn_exp2f(-g.x); d.y = __builtin_amdgcn_exp2f(-g.y); d = d + 1.0f;
                        f32x2 r; r.x = __builtin_amdgcn_rcpf(d.x); r.y = __builtin_amdgcn_rcpf(d.y); const f32x2 ov = (g * up) * r; o[4 * n + e] = ov.x; o[4 * n + e + 1] = ov.y; }
                u32x4 w; w.x = cvt_pk_bf16(o[0], o[1]); w.y = cvt_pk_bf16(o[2], o[3]); w.z = cvt_pk_bf16(o[4], o[5]); w.w = cvt_pk_bf16(o[6], o[7]);
                st16_wt(base + row * FF, w);
            }
    }
};

struct EpiRes {
    static constexpr bool PERM = true, NEED_RSTD = false, I8 = false; typedef f32x4 AccV;
    const float* base32; float* out32; unsigned char* ws; bool dry;
    __device__ __forceinline__ void operator()(const Acc& acc, const Unit& u, int wr, int wc, int fr, int fq, const LAS float* tab) const {
        bf16_t* const xb = (bf16_t*)(ws + WS_XB); float* const ssp = (float*)(ws + WS_SSP);
        const int col0 = u.pn * BM + wc * 32 + 8 * fq;
        u32x4 rb[2][4][2];
        if (!base32) {
#pragma unroll
            for (int ai = 0; ai < 2; ++ai)
#pragma unroll
                for (int m = 0; m < 4; ++m)
#pragma unroll
                    for (int bj = 0; bj < 2; ++bj) rb[ai][m][bj] = *(const u32x4*)(xb + ((size_t)u.pm * BM + ai * HALF + wr * 64 + m * 16 + fr) * D + col0 + bj * HALF);
            asm volatile("" : "+v"(rb[0][0][0]), "+v"(rb[0][0][1]), "+v"(rb[0][1][0]), "+v"(rb[0][1][1]), "+v"(rb[0][2][0]), "+v"(rb[0][2][1]), "+v"(rb[0][3][0]), "+v"(rb[0][3][1]),
                             "+v"(rb[1][0][0]), "+v"(rb[1][0][1]), "+v"(rb[1][1][0]), "+v"(rb[1][1][1]), "+v"(rb[1][2][0]), "+v"(rb[1][2][1]), "+v"(rb[1][3][0]), "+v"(rb[1][3][1]));
        }
#pragma unroll
        for (int ai = 0; ai < 2; ++ai)
#pragma unroll
            for (int m = 0; m < 4; ++m) {
                const size_t row = (size_t)u.pm * BM + ai * HALF + wr * 64 + m * 16 + fr; const size_t off = row * D + col0; float ss = 0.f;
#pragma unroll
                for (int bj = 0; bj < 2; ++bj) { f32x4 b0, b1;
                    if (base32) { b0 = __builtin_nontemporal_load((const f32x4*)(base32 + off + bj * HALF)); b1 = __builtin_nontemporal_load((const f32x4*)(base32 + off + bj * HALF + 4)); }
                    else { const u32x4 b4 = rb[ai][m][bj];
                        b0 = (f32x4){__uint_as_float(b4.x << 16), __uint_as_float(b4.x & 0xFFFF0000u), __uint_as_float(b4.y << 16), __uint_as_float(b4.y & 0xFFFF0000u)};
                        b1 = (f32x4){__uint_as_float(b4.z << 16), __uint_as_float(b4.z & 0xFFFF0000u), __uint_as_float(b4.w << 16), __uint_as_float(b4.w & 0xFFFF0000u)}; }
                    const f32x4 o0 = b0 + acc[ai][bj][m][0], o1 = b1 + acc[ai][bj][m][1];
                    if (out32) {
                        if (!dry) { *(f32x4*)(out32 + off + bj * HALF) = o0; *(f32x4*)(out32 + off + bj * HALF + 4) = o1; }
                        continue; }
                    ss += ((o0[0] * o0[0] + o0[1] * o0[1]) + (o0[2] * o0[2] + o0[3] * o0[3])) + ((o1[0] * o1[0] + o1[1] * o1[1]) + (o1[2] * o1[2] + o1[3] * o1[3]));
                    u32x4 w; w.x = cvt_pk_bf16(o0[0], o0[1]); w.y = cvt_pk_bf16(o0[2], o0[3]); w.z = cvt_pk_bf16(o1[0], o1[1]); w.w = cvt_pk_bf16(o1[2], o1[3]);
                    if (!dry) st16_wt(xb + off + bj * HALF, w); }
                if (out32) continue;
                ss = sum_rows4(ss);
                if (fq == 0 && !dry) ssp[row * 16 + u.pn * 4 + wc] = ss;
            }
    }
};

template <bool I8> __device__ __forceinline__ f32x4 mma16(bf16x8 b, bf16x8 a, f32x4 c) { return __builtin_amdgcn_mfma_f32_16x16x32_bf16(b, a, c, 0, 0, 0); }
template <bool I8> __device__ __forceinline__ i32x4 mma16(bf16x8 b, bf16x8 a, i32x4 c) { return __builtin_amdgcn_mfma_i32_16x16x64_i8(__builtin_bit_cast(i32x4, b), __builtin_bit_cast(i32x4, a), c, 0, 0, 0); }
template <class Epi, bool ALIGN_EPI, bool SP2>
__device__ __forceinline__ void gemm_phase(LAS unsigned char* lds, LAS float* tab, const Gemm g, const StaticOrder& S, const Epi& E, int wave_s) {
    int tid = wave_s * 64 + lane_id(); asm volatile("" : "+v"(tid));
    const int wid = __builtin_amdgcn_readfirstlane(tid >> 6), lane = tid & 63, wr = wid >> 2, wc = wid & 3, fr = lane & 15, fq = lane >> 4;
    const int K = g.K, nt = K / BK, lda = g.lda;
    unsigned voffA[2], voffB[2];
#pragma unroll
    for (int i = 0; i < 2; ++i) { int R, C; stage_rc(tid * 16 + i * 8192, R, C); const int Rb = Epi::PERM ? ((R & ~31) + perm32(R & 31)) : R;
        voffA[i] = (unsigned)(R * lda + C) * 2u; voffB[i] = (unsigned)(Rb * K + C) * 2u; }
    const size_t kstep = (size_t)(BK * 2);
    const size_t hstepA = (size_t)HALF * lda * 2, hstepB = (size_t)HALF * K * 2;
    const size_t tstepA = 2 * hstepA, tstepB = 2 * hstepB;
    const unsigned ldsw = (unsigned)wid * 1024u;
    const int aoff = lds_byte(wr * 64 + fr, fq * 8), boff = lds_byte(wc * 32 + fr, fq * 8);
#define PG8_SA(b, h) (((b) * 2 + (h)) * HTB)
#define PG8_SB(b, h) ((4 + (b) * 2 + (h)) * HTB)
#define PG8_STAGE(bufoff, gbase, voff) do { _Pragma("unroll") for (int _i = 0; _i < 2; ++_i) \
        __builtin_amdgcn_global_load_lds((const unsigned*)((const char*)(gbase) + (voff)[_i]), (LAS unsigned*)(lds + (bufoff) + ldsw + _i * 8192), 16, 0, 0); } while (0)
#define PG8_LDA(dst, b, h) do { _Pragma("unroll") for (int m = 0; m < 4; ++m) _Pragma("unroll") for (int k = 0; k < 2; ++k) dst[m][k] = *(const LAS bf16x8*)(lds + PG8_SA(b, h) + aoff + m * 2048 + k * 1024); } while (0)
#define PG8_LDB(dst, b, h) do { _Pragma("unroll") for (int n = 0; n < 2; ++n) _Pragma("unroll") for (int k = 0; k < 2; ++k) dst[n][k] = *(const LAS bf16x8*)(lds + PG8_SB(b, h) + boff + n * 2048 + k * 1024); } while (0)
#define PG8_MMA(ai, bj, At, Bt) do { __builtin_amdgcn_s_setprio(1); _Pragma("unroll") for (int m = 0; m < 4; ++m) _Pragma("unroll") for (int n = 0; n < 2; ++n) _Pragma("unroll") for (int k = 0; k < 2; ++k) \
        acc[ai][bj][m][n] = mma16<Epi::I8>(Bt[n][k], At[m][k], acc[ai][bj][m][n]); __builtin_amdgcn_s_setprio(0); } while (0)
#define PG8_WAIT_V(n) asm volatile("s_waitcnt vmcnt(" #n ")" ::: "memory")
#define PG8_WAIT_L(n) asm volatile("s_waitcnt lgkmcnt(" #n ")" ::: "memory")
#define PG8_BAR __builtin_amdgcn_s_barrier()
#define PG8_SCHED __builtin_amdgcn_sched_barrier(0)
    Unit cur, nxt; int ui = 0;
    if (!S.next(0, cur)) return;
    typedef typename Epi::AccV AccV; AccV acc[2][2][4][2];
#pragma unroll
    for (int a = 0; a < 2; ++a)
#pragma unroll
        for (int b = 0; b < 2; ++b)
#pragma unroll
            for (int m = 0; m < 4; ++m)
#pragma unroll
                for (int n = 0; n < 2; ++n) acc[a][b][m][n] = AccV{};
    bf16x8 At[4][2], B0[2][2], B1[2][2];
    const char* cA = (const char*)g.A + (size_t)cur.pm * tstepA + (cur.hs > 0 ? hstepA : 0); const char* cB = (const char*)g.Bt + (size_t)cur.pn * tstepB;
    if constexpr (SP2) {
        PG8_STAGE(PG8_SB(0, 0), cB, voffB); PG8_STAGE(PG8_SB(0, 1), cB + hstepB, voffB); PG8_STAGE(PG8_SA(0, 0), cA, voffA); PG8_STAGE(PG8_SA(0, 1), cA + hstepA, voffA);
        if (wr == 1) PG8_BAR;
        PG8_WAIT_V(2); PG8_BAR;
        PG8_STAGE(PG8_SB(1, 0), cB + kstep, voffB); PG8_STAGE(PG8_SA(1, 0), cA + kstep, voffA); PG8_STAGE(PG8_SB(1, 1), cB + hstepB + kstep, voffB);
        PG8_WAIT_V(6); PG8_BAR;
    } else {
        PG8_STAGE(PG8_SB(0, 0), cB, voffB); PG8_STAGE(PG8_SA(0, 0), cA, voffA); PG8_STAGE(PG8_SB(0, 1), cB + hstepB, voffB); PG8_STAGE(PG8_SA(0, 1), cA + hstepA, voffA);
        if (wr == 1) PG8_BAR;
        PG8_WAIT_V(4); PG8_BAR;
        PG8_STAGE(PG8_SB(1, 0), cB + kstep, voffB); PG8_STAGE(PG8_SA(1, 0), cA + kstep, voffA); PG8_STAGE(PG8_SB(1, 1), cB + hstepB + kstep, voffB);
        PG8_WAIT_V(6); PG8_BAR;
    }
    for (;;) {
        const bool has_next = S.next(ui + 1, nxt);
        if constexpr (Epi::NEED_RSTD) {
            if (Epi::I8) { if (tid < 256) tab[(ui & 1) * 256 + tid] = g.ssp[(size_t)cur.pm * BM + tid]; }
            else if (tid < 256) { const f32x4* p = (const f32x4*)(g.ssp + ((size_t)cur.pm * BM + tid) * 16); const f32x4 a = p[0], b = p[1], c = p[2], d = p[3];
                const float s = ((a[0] + a[1]) + (a[2] + a[3])) + ((b[0] + b[1]) + (b[2] + b[3])) + ((c[0] + c[1]) + (c[2] + c[3])) + ((d[0] + d[1]) + (d[2] + d[3]));
                tab[(ui & 1) * 256 + tid] = rsqrtf(s * (1.0f / D) + EPS); }
        }
        const char* nA = has_next ? (const char*)g.A + (size_t)nxt.pm * tstepA + (nxt.hs > 0 ? hstepA : 0) : cA; const char* nB = has_next ? (const char*)g.Bt + (size_t)nxt.pn * tstepB : cB;
        const bool half = cur.hs >= 0;
        for (int t = 0; t < nt; t += 2) {
            const bool last = (t == nt - 2);
            const char* a1 = cA + (size_t)(t + 1) * kstep;
            const char* a2 = last ? nA : cA + (size_t)(t + 2) * kstep; const char* b2 = last ? nB : cB + (size_t)(t + 2) * kstep;
            const char* a3 = a2 + kstep; const char* b3 = b2 + kstep;
            if constexpr (SP2) {
#define PG8_WAIT_VH() do { if (half) PG8_WAIT_V(6); else PG8_WAIT_V(8); } while (0)
            PG8_LDB(B0, 0, 0); PG8_LDB(B1, 0, 1); PG8_SCHED; PG8_LDA(At, 0, 0); if (!half) PG8_STAGE(PG8_SA(1, 1), a1 + hstepA, voffA);
            PG8_WAIT_VH(); PG8_WAIT_L(0); PG8_BAR; PG8_MMA(0, 0, At, B0); PG8_MMA(0, 1, At, B1); PG8_BAR; PG8_SCHED;
            if (!half) PG8_LDA(At, 0, 1); PG8_STAGE(PG8_SB(0, 0), b2, voffB); PG8_STAGE(PG8_SB(0, 1), b2 + hstepB, voffB); PG8_STAGE(PG8_SA(0, 0), a2, voffA);
            PG8_WAIT_VH(); PG8_WAIT_L(0); PG8_BAR; if (!half) { PG8_MMA(1, 0, At, B0); PG8_MMA(1, 1, At, B1); } PG8_BAR; PG8_SCHED;
            PG8_LDB(B0, 1, 0); PG8_LDB(B1, 1, 1); PG8_SCHED; PG8_LDA(At, 1, 0); if (!half) PG8_STAGE(PG8_SA(0, 1), a2 + hstepA, voffA);
            PG8_WAIT_VH(); PG8_WAIT_L(0); PG8_BAR; PG8_MMA(0, 0, At, B0); PG8_MMA(0, 1, At, B1); PG8_BAR; PG8_SCHED;
            if (!half) PG8_LDA(At, 1, 1); PG8_STAGE(PG8_SB(1, 0), b3, voffB); PG8_STAGE(PG8_SB(1, 1), b3 + hstepB, voffB); PG8_STAGE(PG8_SA(1, 0), a3, voffA);
            PG8_WAIT_VH(); PG8_WAIT_L(0); PG8_BAR; if (!half) { PG8_MMA(1, 0, At, B0); PG8_MMA(1, 1, At, B1); } PG8_BAR; PG8_SCHED;
#undef PG8_WAIT_VH
            } else {
            PG8_LDB(B0, 0, 0); PG8_SCHED; PG8_LDA(At, 0, 0); PG8_STAGE(PG8_SA(1, 1), a1 + hstepA, voffA);
            PG8_WAIT_L(8); PG8_BAR; PG8_WAIT_L(0); PG8_MMA(0, 0, At, B0); PG8_BAR; PG8_SCHED;
            PG8_LDB(B1, 0, 1); PG8_STAGE(PG8_SB(0, 0), b2, voffB);
            PG8_BAR; PG8_WAIT_L(0); PG8_MMA(0, 1, At, B1); PG8_BAR;
            PG8_LDA(At, 0, 1); PG8_STAGE(PG8_SA(0, 0), a2, voffA);
            PG8_BAR; PG8_WAIT_L(0); PG8_MMA(1, 0, At, B0); PG8_BAR; PG8_SCHED;
            PG8_STAGE(PG8_SB(0, 1), b2 + hstepB, voffB);
            PG8_WAIT_V(6); PG8_BAR; PG8_MMA(1, 1, At, B1); PG8_BAR;
            PG8_LDB(B0, 1, 0); PG8_SCHED; PG8_LDA(At, 1, 0); PG8_STAGE(PG8_SA(0, 1), a2 + hstepA, voffA);
            PG8_WAIT_L(8); PG8_BAR; PG8_WAIT_L(0); PG8_MMA(0, 0, At, B0); PG8_BAR; PG8_SCHED;
            PG8_LDB(B1, 1, 1); PG8_STAGE(PG8_SB(1, 0), b3, voffB);
            PG8_BAR; PG8_WAIT_L(0); PG8_MMA(0, 1, At, B1); PG8_BAR;
            PG8_LDA(At, 1, 1); PG8_STAGE(PG8_SA(1, 0), a3, voffA);
            PG8_BAR; PG8_WAIT_L(0); PG8_MMA(1, 0, At, B0); PG8_BAR; PG8_SCHED;
            PG8_STAGE(PG8_SB(1, 1), b3 + hstepB, voffB);
            PG8_WAIT_V(6); PG8_BAR; PG8_MMA(1, 1, At, B1); PG8_BAR;
            }
        }
        if constexpr (ALIGN_EPI) { if (wr == 0) PG8_BAR; }
        E(acc, cur, wr, wc, fr, fq, (const LAS float*)(tab + (ui & 1) * 256));
        if (!has_next) break;
#pragma unroll
        for (int a = 0; a < 2; ++a)
#pragma unroll
            for (int b = 0; b < 2; ++b)
#pragma unroll
                for (int m = 0; m < 4; ++m)
#pragma unroll
                    for (int n = 0; n < 2; ++n) acc[a][b][m][n] = AccV{};
        cur = nxt; cA = nA; cB = nB; ++ui;
        if constexpr (ALIGN_EPI) { if (wr == 1) PG8_BAR; }
    }
    PG8_WAIT_V(0);
    if constexpr (!ALIGN_EPI) { if (wr == 0) PG8_BAR; }
    PG8_BAR;
#undef PG8_SA
#undef PG8_SB
#undef PG8_STAGE
#undef PG8_LDA
#undef PG8_LDB
#undef PG8_MMA
#undef PG8_WAIT_V
#undef PG8_WAIT_L
#undef PG8_BAR
#undef PG8_SCHED
}
}

typedef GAS unsigned gu32;
#define RLX_AGENT __ATOMIC_RELAXED, __HIP_MEMORY_SCOPE_AGENT
#define LDS_WAIT() asm volatile("s_waitcnt lgkmcnt(0)" ::: "memory")
#define VM_WAIT() asm volatile("s_waitcnt vmcnt(0)" ::: "memory")
__device__ __forceinline__ unsigned f2bf(float f) { unsigned u = __builtin_bit_cast(unsigned, f); return (u + 0x7fffu + ((u >> 16) & 1u)) >> 16; }
__device__ __forceinline__ unsigned pk2(float lo, float hi) { return f2bf(lo) | (f2bf(hi) << 16); }
__device__ __forceinline__ float bf2f(unsigned short b) { return __builtin_bit_cast(float, (unsigned)b << 16); }

#define XB_TMO      128
#define XB_XCNT(j)  (256  + 64 * (j))
#define XB_XSUB(j)  (1280 + 64 * (j))
#define XB_XGEN(j)  (2304 + 64 * (j))
#define XB_TOP      3328
#define XB_TOPGEN   3392
#define XCD_BAR_WORDS 3456
#define XB_SPIN_CAP (1u << 18)
__device__ __forceinline__ unsigned xb_ld(unsigned* p)              { return __hip_atomic_load(p, __ATOMIC_RELAXED, __HIP_MEMORY_SCOPE_AGENT); }
__device__ __forceinline__ unsigned xb_add(unsigned* p, unsigned v) { return __hip_atomic_fetch_add(p, v, __ATOMIC_RELAXED, __HIP_MEMORY_SCOPE_AGENT); }
__device__ __forceinline__ unsigned xb_xcc_id() { return (unsigned)__builtin_amdgcn_s_getreg((3 << 11) | 20) & 0xFu; }
#define XB_SPIN(cond, bar) do { unsigned _sp = 0; while (cond) { __builtin_amdgcn_s_sleep(1); \
    if ((++_sp & 255u) == 0u) { if (xb_ld(&(bar)[XB_TMO])) break; if (_sp > XB_SPIN_CAP) { atomicAdd(&(bar)[XB_TMO], 1u); break; } } } } while (0)
struct XcdBarrier { unsigned* bar; unsigned x; volatile LAS unsigned* st; };
__device__ __forceinline__ void xcd_barrier_complete(unsigned* bar, unsigned x, unsigned& nloc, unsigned& nx) {
    const unsigned G = gridDim.x * gridDim.y * gridDim.z;
    unsigned sum, cnt, mine, sp = 0u;
    for (;;) {
        sum = 0u; cnt = 0u; mine = 0u;
#pragma unroll
        for (unsigned j = 0; j < 16; ++j) { const unsigned c = xb_ld(&bar[XB_XCNT(j)]); sum += c; cnt += (c > 0u) ? 1u : 0u; mine = (j == x) ? c : mine; }
        if (sum == G) break;
        __builtin_amdgcn_s_sleep(1);
        if ((++sp & 255u) == 0u) { if (xb_ld(&bar[XB_TMO])) break; if (sp > XB_SPIN_CAP) { atomicAdd(&bar[XB_TMO], 1u); break; } }
    }
    nloc = mine > 0u ? mine : 1u; nx = cnt > 0u ? cnt : 1u;
}
__device__ __forceinline__ void xcd_barrier_impl(const XcdBarrier& b, bool leader) {
    asm volatile("s_waitcnt vmcnt(0)" ::: "memory");
    __syncthreads();
    if (leader) {
        unsigned* bar = b.bar;
        __builtin_amdgcn_s_waitcnt(0);
        unsigned nloc = b.st[0], nx = b.st[1];
        if (nloc == 0u) { xcd_barrier_complete(bar, b.x, nloc, nx); b.st[0] = nloc; b.st[1] = nx; }
        const unsigned old = xb_add(&bar[XB_XSUB(b.x)], 1u);
        const unsigned gen = old / nloc;
        if (old + 1u == (gen + 1u) * nloc) {
            __builtin_amdgcn_fence(__ATOMIC_RELEASE, "agent");
            asm volatile("s_waitcnt vmcnt(0)" ::: "memory");
            const unsigned og = xb_add(&bar[XB_TOP], 1u);
            const unsigned tg = og / nx;
            if (og + 1u != (tg + 1u) * nx) XB_SPIN(xb_ld(&bar[XB_TOP]) < (tg + 1u) * nx, bar);
            __builtin_amdgcn_fence(__ATOMIC_ACQUIRE, "agent");
            asm volatile("s_waitcnt vmcnt(0)" ::: "memory");
        } else {
            XB_SPIN(xb_ld(&bar[XB_TOP]) < (gen + 1u) * nx, bar);
            __builtin_amdgcn_fence(__ATOMIC_ACQUIRE, "agent");
            asm volatile("s_waitcnt vmcnt(0)" ::: "memory");
        }
    }
    __syncthreads();
}

struct Args { const float* in[14]; float* out; unsigned char* ws; };
template <int SLOT> __device__ __forceinline__ unsigned long long karg_u64() {
#if defined(__HIP_DEVICE_COMPILE__)
    auto ka = __builtin_amdgcn_kernarg_segment_ptr(); unsigned long long v;
    asm volatile("s_load_dwordx2 %0, %1, %2\n\ts_waitcnt lgkmcnt(0)" : "=s"(v) : "s"(ka), "i"(SLOT * 8) : "memory");
    return v;
#else
    return 0ull;
#endif
}
template <int I> __device__ __forceinline__ const float* karg_in() { return (const float*)(const GAS float*)karg_u64<I>(); }
__device__ __forceinline__ float* karg_out() { return (float*)(GAS float*)karg_u64<14>(); }
__device__ __forceinline__ unsigned char* karg_ws() { return (unsigned char*)(GAS unsigned char*)karg_u64<15>(); }
struct Frame {
    LAS unsigned char* lds; int tid, lane, wave, vcu, G;
};


__device__ __forceinline__ float wave_sum(float v) {
#pragma unroll
    for (int o = 1; o < 64; o <<= 1) v += __shfl_xor(v, o);
    return v;
}

__device__ __forceinline__ void pool_item(const float* Wo, const float* P, const float* sc, bf16_t* WT, int k0, int n0, LAS float* scr, int lane) {
    const int c4 = lane & 7, g = (k0 - 512) >> 7, cb = ((k0 - 512) & 127) + (lane >> 3);
    const float* s = sc + 128 * g; const float* w = Wo + (size_t)(512 + 128 * g) * D + n0 + 4 * c4; const float* pp = P + ((size_t)g * 128 + cb) * 128;
    f32x4 acc[8];
#pragma unroll
    for (int i = 0; i < 8; ++i) acc[i] = (f32x4){0.f, 0.f, 0.f, 0.f};
#pragma unroll 2
    for (int d = 0; d < 128; d += 4) {
        const f32x4 s4 = *(const f32x4*)(s + d);
        f32x4 wv[4], p4[8];
#pragma unroll
        for (int j = 0; j < 4; ++j) wv[j] = *(const f32x4*)(w + (size_t)(d + j) * D);
#pragma unroll
        for (int i = 0; i < 8; ++i) p4[i] = *(const f32x4*)(pp + (size_t)(8 * i) * 128 + d);
#pragma unroll
        for (int i = 0; i < 8; ++i)
#pragma unroll
            for (int j = 0; j < 4; ++j) { const float ps = p4[i][j] * s4[j]; acc[i][0] = fmaf(ps, wv[j][0], acc[i][0]); acc[i][1] = fmaf(ps, wv[j][1], acc[i][1]); acc[i][2] = fmaf(ps, wv[j][2], acc[i][2]); acc[i][3] = fmaf(ps, wv[j][3], acc[i][3]); }
    }
#pragma unroll
    for (int i = 0; i < 8; ++i) { const int kk = 8 * i + (lane >> 3); LAS float* dd = scr + kk * 33 + 4 * c4; dd[0] = acc[i][0]; dd[1] = acc[i][1]; dd[2] = acc[i][2]; dd[3] = acc[i][3]; }
    LDS_WAIT(); asm volatile("" ::: "memory");
    const int c = lane & 7;
#pragma unroll
    for (int j = 0; j < 4; ++j) { const int n = (lane >> 3) + 8 * j; const LAS float* sp = scr + (8 * c) * 33 + n;
        u32x4 o; o.x = pk2(sp[0 * 33], sp[1 * 33]); o.y = pk2(sp[2 * 33], sp[3 * 33]); o.z = pk2(sp[4 * 33], sp[5 * 33]); o.w = pk2(sp[6 * 33], sp[7 * 33]);
        *(GAS u32x4*)(WT + (size_t)(n0 + n) * D + k0 + 8 * c) = o; }
    LDS_WAIT(); asm volatile("" ::: "memory");
}
template <class F> __device__ __forceinline__ void tr_item(const F& f, bf16_t* WT, int Kd, int k0, int n0, LAS float* scr, int lane) {
    const int c4 = lane & 7;
#pragma unroll
    for (int i = 0; i < 8; ++i) { const int kk = 8 * i + (lane >> 3); const f32x4 v = f(k0 + kk, n0 + 4 * c4); LAS float* d = scr + kk * 33 + 4 * c4; d[0] = v[0]; d[1] = v[1]; d[2] = v[2]; d[3] = v[3]; }
    LDS_WAIT(); asm volatile("" ::: "memory");
    const int c = lane & 7;
#pragma unroll
    for (int j = 0; j < 4; ++j) { const int n = (lane >> 3) + 8 * j; const LAS float* s = scr + (8 * c) * 33 + n;
        u32x4 o; o.x = pk2(s[0 * 33], s[1 * 33]); o.y = pk2(s[2 * 33], s[3 * 33]); o.z = pk2(s[4 * 33], s[5 * 33]); o.w = pk2(s[6 * 33], s[7 * 33]);
        *(GAS u32x4*)(WT + (size_t)(n0 + n) * Kd + k0 + 8 * c) = o; }
    LDS_WAIT(); asm volatile("" ::: "memory");
}
__device__ __forceinline__ int ein_src(int np) {
    const int pn = np >> 8, cl = np & 255, bj = cl >> 7, wc = (cl >> 5) & 3, i = cl & 31;
    const int L = 256 * pn + 64 * wc + 32 * bj + i;
    if (L < 1024) return L;
    if (L < 1536) return 1092 + (L - 1024);
    if (L < 1600) return 1024 + (L - 1536);
    if (L < 1604) return 1088 + (L - 1600);
    return -1;
}
struct FEin { const float* W; const float* g; __device__ __forceinline__ f32x4 operator()(int k, int np) const { const int s = ein_src(np); if (s < 0) return (f32x4){0.f, 0.f, 0.f, 0.f}; return *(const f32x4*)(W + (size_t)k * EIN_SRC + s) * g[k]; } };
struct FPlain { const float* W; int N; const float* g; __device__ __forceinline__ f32x4 operator()(int k, int np) const { const f32x4 v = *(const f32x4*)(W + (size_t)k * N + np); return g ? v * g[k] : v; } };
struct FUp { const float* W; const float* g; __device__ __forceinline__ f32x4 operator()(int k, int np) const {
    const int pn = np >> 8, j = np & 127; return *(const f32x4*)(W + (size_t)k * FF + 128 * pn + j) * g[k]; } };
struct FPool { const float* Wo; const float* P; const float* sc; __device__ __forceinline__ f32x4 operator()(int k, int n) const {
    const int g = (k - 512) >> 7, c = (k - 512) & 127; const float* p = P + ((size_t)g * 128 + c) * 128; const float* s = sc + 128 * g; const float* w = Wo + (size_t)(512 + 128 * g) * D + n;
    f32x4 a = {0.f, 0.f, 0.f, 0.f};
#pragma unroll 8
    for (int d = 0; d < 128; ++d) { const float ps = p[d] * s[d]; const f32x4 wv = *(const f32x4*)(w + (size_t)d * D); a[0] = fmaf(ps, wv[0], a[0]); a[1] = fmaf(ps, wv[1], a[1]); a[2] = fmaf(ps, wv[2], a[2]); a[3] = fmaf(ps, wv[3], a[3]); }
    return a; } };

struct TrDesc { const float* W; const float* g; bf16_t* dst; int srcN, Kd, k0, n0, kind; };
__device__ __forceinline__ void tr_decode(int r, TrDesc& d, unsigned char* ws) {
    constexpr int I_EOUT = (512 / 64) * (D / 32), I_EIN = (D / 64) * (EIN / 32), I_OQKV = (D / 64) * (3 * D / 32), I_OOUT = (D / 64) * (D / 32), I_UP = (D / 64) * (2 * FF / 32), I_DN = (FF / 64) * (D / 32);
    d.g = nullptr; d.kind = 0; d.Kd = D;
    if (r < 2 * I_EOUT) { const int l = r / I_EOUT; r %= I_EOUT; const int nblk = D / 32; d.k0 = 64 * (r / nblk); d.n0 = 32 * (r % nblk);
        d.W = karg_in<4>() + (size_t)l * D * D; d.srcN = D; d.dst = (bf16_t*)(ws + WS_W_EOUT + l * SZ_SQ); return; } r -= 2 * I_EOUT;
    if (r < 2 * I_EIN) { const int l = r / I_EIN; r %= I_EIN; const int nblk = EIN / 32; d.k0 = 64 * (r / nblk); d.n0 = 32 * (r % nblk);
        d.W = karg_in<3>() + (size_t)l * D * EIN_SRC; d.srcN = EIN_SRC; d.g = karg_in<1>() + (size_t)(2 * l) * D; d.kind = 1; d.dst = (bf16_t*)(ws + WS_W_EIN + l * SZ_EIN); return; } r -= 2 * I_EIN;
    if (r < 2 * I_OOUT) { const int l = r / I_OOUT; r %= I_OOUT; const int nblk = D / 32; d.k0 = 64 * (r / nblk); d.n0 = 32 * (r % nblk);
        d.W = karg_in<10>() + (size_t)l * D * D; d.srcN = D; d.dst = (bf16_t*)(ws + WS_W_OOUT + l * SZ_SQ); return; } r -= 2 * I_OOUT;
    { const int l = r / I_DN; r %= I_DN; const int nblk = D / 32; d.k0 = 64 * (r / nblk); d.n0 = 32 * (r % nblk);
        d.W = karg_in<13>() + (size_t)l * FF * D; d.srcN = D; d.Kd = FF; d.dst = (bf16_t*)(ws + WS_W_DN + l * SZ_DN); }
}
__device__ __forceinline__ void tr_load(const TrDesc& d, f32x4 (&v)[8], float (&gv)[8], int lane) {
    const int np = d.n0 + 4 * (lane & 7);
    const int col = d.kind == 0 ? np : (d.kind == 1 ? ein_src(np) : 128 * (np >> 8) + (np & 127));
    const int colc = col >= 0 ? col : 0;
    const float* gp = d.g ? d.g : d.W;
#pragma unroll
    for (int i = 0; i < 8; ++i) { const int k = d.k0 + 8 * i + (lane >> 3); v[i] = __builtin_nontemporal_load((const f32x4*)(d.W + (size_t)k * d.srcN + colc)); gv[i] = gp[k]; }
}
__device__ __forceinline__ void tr_store(const TrDesc& d, const f32x4 (&v)[8], const float (&gv)[8], LAS float* scr, int lane) {
    const int c4 = lane & 7;
    const int np = d.n0 + 4 * c4; const bool pad = d.kind == 1 && ein_src(np) < 0; const bool hasg = d.g != nullptr;
#pragma unroll
    for (int i = 0; i < 8; ++i) { const int kk = 8 * i + (lane >> 3); LAS float* p = scr + kk * 33 + 4 * c4; const float gm = pad ? 0.f : (hasg ? gv[i] : 1.f);
        p[0] = v[i][0] * gm; p[1] = v[i][1] * gm; p[2] = v[i][2] * gm; p[3] = v[i][3] * gm; }
    LDS_WAIT(); asm volatile("" ::: "memory");
    const int c = lane & 7;
#pragma unroll
    for (int j = 0; j < 4; ++j) { const int n = (lane >> 3) + 8 * j; const LAS float* s = scr + (8 * c) * 33 + n;
        u32x4 o; o.x = pk2(s[0 * 33], s[1 * 33]); o.y = pk2(s[2 * 33], s[3 * 33]); o.z = pk2(s[4 * 33], s[5 * 33]); o.w = pk2(s[6 * 33], s[7 * 33]);
        *(GAS u32x4*)(d.dst + (size_t)(d.n0 + n) * d.Kd + d.k0 + 8 * c) = o; }
    LDS_WAIT(); asm volatile("" ::: "memory");
}
constexpr int N_STRIPS = 2 * FF / 32;
__device__ __forceinline__ void q8_strip(const float* W, int pitch, const float* g, signed char* dst, float* sw, int n0, LAS float* scr, int lane, float swm = 1.0f  ) {
    const int kr = lane >> 3;
    f32x4 mx = {0.f, 0.f, 0.f, 0.f};
#pragma unroll 2
    for (int kb = 0; kb < D / 64; ++kb) {
#pragma unroll
        for (int i = 0; i < 8; ++i) { const int k = 64 * kb + 8 * i + kr; const f32x4 v = __builtin_nontemporal_load((const f32x4*)(W + (size_t)k * pitch)) * g[k];
            mx[0] = __builtin_fmaxf(mx[0], __builtin_fabsf(v[0])); mx[1] = __builtin_fmaxf(mx[1], __builtin_fabsf(v[1])); mx[2] = __builtin_fmaxf(mx[2], __builtin_fabsf(v[2])); mx[3] = __builtin_fmaxf(mx[3], __builtin_fabsf(v[3])); } }
#pragma unroll
    for (int c = 0; c < 4; ++c) { float m = mx[c]; m = __builtin_fmaxf(m, shfl_xor_f(m, 8, lane)); m = __builtin_fmaxf(m, shfl_xor_f(m, 16, lane)); m = __builtin_fmaxf(m, shfl_xor_f(m, 32, lane)); mx[c] = m; }
    f32x4 inv, step;
#pragma unroll
    for (int c = 0; c < 4; ++c) { step[c] = mx[c] > 0.f ? mx[c] * (1.0f / 127.0f) : 1.0f; inv[c] = mx[c] > 0.f ? 127.0f / mx[c] : 0.f; }
    if (lane < 8) *(f32x4*)(sw + n0 + 4 * lane) = step * swm;
    for (int kb = 0; kb < D / 64; ++kb) {
#pragma unroll
        for (int i = 0; i < 8; ++i) { const int kk = 8 * i + kr; const int k = 64 * kb + kk; const f32x4 v = __builtin_nontemporal_load((const f32x4*)(W + (size_t)k * pitch)) * g[k];
            LAS float* p = scr + kk * 33 + 4 * (lane & 7); p[0] = __builtin_rintf(v[0] * inv[0]); p[1] = __builtin_rintf(v[1] * inv[1]); p[2] = __builtin_rintf(v[2] * inv[2]); p[3] = __builtin_rintf(v[3] * inv[3]); }
        LDS_WAIT(); asm volatile("" ::: "memory");
        const int c = lane & 7;
#pragma unroll
        for (int j = 0; j < 4; ++j) { const int n = (lane >> 3) + 8 * j; const LAS float* sp = scr + (8 * c) * 33 + n;
            u32x2 o;
            o.x = ((unsigned)(int)sp[0 * 33] & 0xFFu) | (((unsigned)(int)sp[1 * 33] & 0xFFu) << 8) | (((unsigned)(int)sp[2 * 33] & 0xFFu) << 16) | (((unsigned)(int)sp[3 * 33] & 0xFFu) << 24);
            o.y = ((unsigned)(int)sp[4 * 33] & 0xFFu) | (((unsigned)(int)sp[5 * 33] & 0xFFu) << 8) | (((unsigned)(int)sp[6 * 33] & 0xFFu) << 16) | (((unsigned)(int)sp[7 * 33] & 0xFFu) << 24);
            *(GAS u32x2*)(dst + (size_t)(n0 + n) * D + 64 * kb + 8 * c) = o; }
        LDS_WAIT(); asm volatile("" ::: "memory");
    }
}
__device__ __forceinline__ void up_strip(int layer, int strip, unsigned char* ws, LAS float* scr, int lane) {
    const int n0 = 32 * strip; const float* w1p = karg_in<11>(); const float* w3p = karg_in<12>();
    const float* W = (((n0 >> 7) & 1) ? w3p : w1p) + (size_t)layer * D * FF + 128 * (n0 >> 8) + (n0 & 127) + 4 * (lane & 7);
    q8_strip(W, FF, karg_in<2>() + (size_t)layer * D, (signed char*)(ws + WS_W_UP + layer * SZ_UP), (float*)(ws + WS_SW) + (size_t)layer * 2 * FF, n0, scr, lane, ((n0 >> 7) & 1) ? 0.6931471805599453f : 1.4426950408889634f);
}
constexpr int Q_STRIPS = 3 * D / 32;
__device__ __forceinline__ void qkv_strip(int l, int strip, unsigned char* ws, LAS float* scr, int lane) {
    const int n0 = 32 * strip;
    q8_strip(karg_in<9>() + (size_t)l * D * 3 * D + n0 + 4 * (lane & 7), 3 * D, karg_in<1>() + (size_t)(2 * l + 1) * D, (signed char*)(ws + WS_W_OQKV + l * SZ_OQKV), (float*)(ws + WS_SWQ) + (size_t)l * 3 * D, n0, scr, lane);
}
__device__ __forceinline__ void quant_rows(unsigned char* ws, size_t xq_off, size_t sar_off, int gw, int NGW, int lane) {
    const bf16_t* xb = (const bf16_t*)(ws + WS_XB); signed char* xq = (signed char*)(ws + xq_off); float* sar = (float*)(ws + sar_off); const float* ssp = (const float*)(ws + WS_SSP);
    for (int m = gw; m < M; m += 8 * NGW) {
        u32x4 a[8][2]; float mx[8];
#pragma unroll
        for (int q = 0; q < 8; ++q) { const u32x4* p = (const u32x4*)(xb + (size_t)(m + q * NGW) * D + 16 * lane); a[q][0] = p[0]; a[q][1] = p[1]; }
        float ssv = 0.f;
        if (lane < 32) { const f32x4 s4 = *(const f32x4*)(ssp + (size_t)(m + (lane >> 2) * NGW) * 16 + 4 * (lane & 3)); ssv = (s4[0] + s4[1]) + (s4[2] + s4[3]); }
        ssv += shfl_xor_f(ssv, 1, lane); ssv += shfl_xor_f(ssv, 2, lane);
#pragma unroll
        for (int q = 0; q < 8; ++q) { float t = 0.f;
#pragma unroll
            for (int i = 0; i < 8; ++i) { const unsigned wd = a[q][i >> 2][i & 3]; t = __builtin_fmaxf(t, __builtin_fmaxf(__builtin_fabsf(__uint_as_float(wd << 16)), __builtin_fabsf(__uint_as_float(wd & 0xFFFF0000u)))); }
            mx[q] = t; }
#pragma unroll
        for (int o = 1; o < 64; o <<= 1) {
#pragma unroll
            for (int q = 0; q < 8; ++q) mx[q] = __builtin_fmaxf(mx[q], shfl_xor_f(mx[q], o, lane)); }
        float mysar = 0.f;
#pragma unroll
        for (int q = 0; q < 8; ++q) { const int row = m + q * NGW;
            const float inv = mx[q] > 0.f ? 127.0f / mx[q] : 0.f, step = mx[q] > 0.f ? mx[q] * (1.0f / 127.0f) : 1.0f;
            if (lane == 4 * q) mysar = rsqrtf(ssv * (1.0f / D) + EPS) * step;
            u32x4 o4;
#pragma unroll
            for (int w4 = 0; w4 < 4; ++w4) { const unsigned w0 = a[q][w4 >> 1][2 * (w4 & 1)], w1 = a[q][w4 >> 1][2 * (w4 & 1) + 1];
                const int q0 = (int)__builtin_rintf(__uint_as_float(w0 << 16) * inv), q1 = (int)__builtin_rintf(__uint_as_float(w0 & 0xFFFF0000u) * inv);
                const int q2 = (int)__builtin_rintf(__uint_as_float(w1 << 16) * inv), q3 = (int)__builtin_rintf(__uint_as_float(w1 & 0xFFFF0000u) * inv);
                o4[w4] = ((unsigned)q0 & 0xFFu) | (((unsigned)q1 & 0xFFu) << 8) | (((unsigned)q2 & 0xFFu) << 16) | (((unsigned)q3 & 0xFFu) << 24); }
            st16_wt(xq + (size_t)row * D + 16 * lane, o4);
        }
        if (lane < 32 && (lane & 3) == 0) sar[m + (lane >> 2) * NGW] = mysar;
    }
}
__device__ __forceinline__ void p0_prologue(const Frame& F) {
    LAS float* scr = (LAS float*)(F.lds + F.wave * 16384);
    const int gw = F.vcu * 8 + F.wave, NGW = F.G * 8;
    unsigned char* ws = karg_ws();
    constexpr int I_POOL = (512 / 64) * (D / 32);
    constexpr int I_EOUT = (512 / 64) * (D / 32), I_EIN = (D / 64) * (EIN / 32), I_OQKV = (D / 64) * (3 * D / 32), I_OOUT = (D / 64) * (D / 32), I_UP = (D / 64) * (2 * FF / 32), I_DN = (FF / 64) * (D / 32);
    constexpr int NITEMS = 2 * (I_EOUT + I_EIN + I_OOUT) + 4 * I_DN;
    const int role = gw & 3, ridx = gw >> 2;
    constexpr int NSTR = 4 * N_STRIPS + 2 * Q_STRIPS;
    if (role == 0 && ridx < 2 * I_POOL) { const int it = ridx; const int l = it / I_POOL, r = it % I_POOL; const int nblk = D / 32, kb = r / nblk, nb = r % nblk;
        pool_item(karg_in<4>() + (size_t)l * D * D, karg_in<7>() + (size_t)l * 4 * 128 * 128, karg_in<8>() + (size_t)l * 512, (bf16_t*)(ws + WS_W_EOUT + l * SZ_SQ), 512 + 64 * kb, 32 * nb, scr, F.lane); }
    else if (role == 1 || (role == 2 && ridx < NSTR - 512)) { const int sidx = role == 1 ? ridx : 512 + ridx;
        if (sidx < 4 * N_STRIPS) up_strip(sidx / N_STRIPS, sidx % N_STRIPS, ws, scr, F.lane); else { const int q = sidx - 4 * N_STRIPS; qkv_strip(q / Q_STRIPS, q % Q_STRIPS, ws, scr, F.lane); } }
    else if (role >= 2) {
      const int NPL = 512 + (512 - (NSTR - 512));
      int it = role == 3 ? ridx : 512 + ridx - (NSTR - 512);
      TrDesc dA, dB; f32x4 vA[8], vB[8]; float gA[8], gB[8];
      if (it < NITEMS) { tr_decode(it, dA, ws); tr_load(dA, vA, gA, F.lane); }
      while (it < NITEMS) {
          const int itB = it + NPL;
          if (itB < NITEMS) { tr_decode(itB, dB, ws); tr_load(dB, vB, gB, F.lane); }
          tr_store(dA, vA, gA, scr, F.lane);
          if (itB >= NITEMS) break;
          const int itA = itB + NPL;
          if (itA < NITEMS) { tr_decode(itA, dA, ws); tr_load(dA, vA, gA, F.lane); }
          tr_store(dB, vB, gB, scr, F.lane);
          it = itA;
      } }
    const float* x = karg_in<0>();
    bf16_t* xb = (bf16_t*)(ws + WS_XB); float* ssp = (float*)(ws + WS_SSP);
    const bool is_strip = (role == 1) || (role == 2 && ridx < NSTR - 512);
    if (!is_strip) {
        const int NRW = NGW - NSTR;
        const int rw = role == 0 ? ridx : (role == 3 ? 512 + ridx : 1024 + ridx - (NSTR - 512));
        for (int m = rw; m < M; m += 2 * NRW) {
            const int m2 = m + NRW; const bool two = m2 < M;
            const GAS f32x4* xr = (const GAS f32x4*)(x + (size_t)m * D) + F.lane; const GAS f32x4* xr2 = (const GAS f32x4*)(x + (size_t)(two ? m2 : m) * D) + F.lane; f32x4 v[4], v2[4]; float s = 0.f, s2 = 0.f;
#pragma unroll
            for (int j = 0; j < 4; ++j) { v[j] = __builtin_nontemporal_load(&xr[64 * j]); v2[j] = __builtin_nontemporal_load(&xr2[64 * j]); }
#pragma unroll
            for (int j = 0; j < 4; ++j) { s += (v[j][0] * v[j][0] + v[j][1] * v[j][1]) + (v[j][2] * v[j][2] + v[j][3] * v[j][3]); s2 += (v2[j][0] * v2[j][0] + v2[j][1] * v2[j][1]) + (v2[j][2] * v2[j][2] + v2[j][3] * v2[j][3]); }
            s = wave_sum(s); s2 = wave_sum(s2);
            GAS unsigned long long* o8 = (GAS unsigned long long*)(xb + (size_t)m * D) + F.lane;
#pragma unroll
            for (int j = 0; j < 4; ++j) o8[64 * j] = (unsigned long long)pk2(v[j][0], v[j][1]) | ((unsigned long long)pk2(v[j][2], v[j][3]) << 32);
            if (F.lane < 16) ssp[(size_t)m * 16 + F.lane] = (F.lane == 0) ? s : 0.f;
            if (two) { GAS unsigned long long* o82 = (GAS unsigned long long*)(xb + (size_t)m2 * D) + F.lane;
#pragma unroll
                for (int j = 0; j < 4; ++j) o82[64 * j] = (unsigned long long)pk2(v2[j][0], v2[j][1]) | ((unsigned long long)pk2(v2[j][2], v2[j][3]) << 32);
                if (F.lane < 16) ssp[(size_t)m2 * 16 + F.lane] = (F.lane == 0) ? s2 : 0.f; }
        }
    }
}

__device__ __forceinline__ int crow(int r, int hi) { return (r & 3) + 8 * (r >> 2) + 4 * hi; }
typedef short v4i16_t __attribute__((ext_vector_type(4)));
__device__ __forceinline__ s16x4 vtr(const LAS char* p) { return __builtin_bit_cast(s16x4, __builtin_amdgcn_ds_read_tr16_b64_v4i16((LAS v4i16_t*)p)); }
typedef __bf16 bf16x2_t __attribute__((ext_vector_type(2)));
__device__ __forceinline__ unsigned cvtpk(float lo, float hi) { f32x2 v = {lo, hi}; bf16x2_t b = __builtin_convertvector(v, bf16x2_t); return __builtin_bit_cast(unsigned, b); }
__device__ __forceinline__ float swap_other(float v, int hi) {
    auto rr = __builtin_amdgcn_permlane32_swap(__float_as_uint(v), __float_as_uint(v), false, false);
    return __uint_as_float(hi ? rr[0] : rr[1]);
}
__device__ __forceinline__ unsigned swap_or(unsigned v) { auto rr = __builtin_amdgcn_permlane32_swap(v, v, false, false); return rr[0] | rr[1]; }

__device__ __forceinline__ void load_kfrag(bf16x8 (&kf)[8], const bf16_t* Kt  , int pitch, int r32, int hi) {
    const unsigned koff = (unsigned)(r32 * pitch + 8 * hi) * 2u;
#pragma unroll
    for (int d0 = 0; d0 < 4; ++d0)
#pragma unroll
        for (int h = 0; h < 2; ++h) kf[2 * d0 + h] = *(const bf16x8*)((const char*)Kt + (size_t)(32 * h * pitch + 16 * d0) * 2 + koff);
}
__device__ __forceinline__ void qkt(f32x16& p0, f32x16& p1, const bf16x8 (&kf)[8], const bf16x8 (&qr)[4]) {
    p0 = f32x16{}; p1 = f32x16{};
#pragma unroll
    for (int d0 = 0; d0 < 4; ++d0) {
        p0 = __builtin_amdgcn_mfma_f32_32x32x16_bf16(kf[2 * d0], qr[d0], p0, 0, 0, 0);
        p1 = __builtin_amdgcn_mfma_f32_32x32x16_bf16(kf[2 * d0 + 1], qr[d0], p1, 0, 0, 0);
    }
}
__device__ __forceinline__ void load_vtile(u32x4 (&vr)[8], const bf16_t* Vt  , int pitch, int lane) {
    const unsigned voff = (unsigned)((lane >> 2) * pitch + (lane & 3) * 8) * 2u;
#pragma unroll
    for (int p = 0; p < 8; ++p) vr[p] = *(const u32x4*)((const char*)Vt + (size_t)(16 * (p & 3) * pitch + (p >> 2) * 32) * 2 + voff);
}
__device__ __forceinline__ void glds16_s(const void* sbase  , unsigned voff  , unsigned lds_dst  ) {
    unsigned keep;
    asm volatile("s_nop 4\n\ts_mov_b32 %0, m0\n\ts_mov_b32 m0, %3\n\ts_nop 0\n\tglobal_load_lds_dwordx4 %1, %2\n\ts_mov_b32 m0, %0" : "=&s"(keep) : "v"(voff), "s"(sbase), "s"(lds_dst) : "memory");
}
__device__ __forceinline__ void dma_vtile(const bf16_t* Vt  , int pitch, int lane, LAS char* vslot  ) {
    const unsigned voff = (unsigned)((lane >> 2) * pitch + (lane & 3) * 8) * 2u;
    const unsigned l0 = (unsigned)(size_t)vslot;
#pragma unroll
    for (int p = 0; p < 8; ++p) glds16_s((const char*)Vt + (size_t)(16 * (p & 3) * pitch + (p >> 2) * 32) * 2, voff, l0 + p * 1024);
}
__device__ __forceinline__ void store_vtile(const u32x4 (&vr)[8], LAS char* vslot, int lane) {
#pragma unroll
    for (int p = 0; p < 8; ++p) *(LAS u32x4*)(vslot + p * 1024 + lane * 16) = vr[p];
}
__device__ __forceinline__ void pv_load(bf16x8 (&vf)[8], const LAS char* vp0) {
#pragma unroll
    for (int ks = 0; ks < 4; ++ks)
#pragma unroll
        for (int d0 = 0; d0 < 2; ++d0) {
            const s16x4 lo = vtr(vp0 + d0 * 4096 + ks * 1024), hi4 = vtr(vp0 + d0 * 4096 + ks * 1024 + 512);
            vf[2 * ks + d0] = (bf16x8){lo[0], lo[1], lo[2], lo[3], hi4[0], hi4[1], hi4[2], hi4[3]};
        }
}
__device__ __forceinline__ void pv_mma(f32x16 (&o)[2], const bf16x8 (&vf)[8], const f32x16& P0, const f32x16& P1) {
    u32x4 pw[4];
#pragma unroll
    for (int i = 0; i < 4; ++i) { pw[0][i] = cvtpk(P0[2 * i], P0[2 * i + 1]); pw[1][i] = cvtpk(P0[8 + 2 * i], P0[9 + 2 * i]); pw[2][i] = cvtpk(P1[2 * i], P1[2 * i + 1]); pw[3][i] = cvtpk(P1[8 + 2 * i], P1[9 + 2 * i]); }
#pragma unroll
    for (int ks = 0; ks < 4; ++ks)
#pragma unroll
        for (int d0 = 0; d0 < 2; ++d0) o[d0] = __builtin_amdgcn_mfma_f32_32x32x16_bf16(__builtin_bit_cast(bf16x8, pw[ks]), vf[2 * ks + d0], o[d0], 0, 0, 0);
}
__device__ __forceinline__ void pv(f32x16 (&o)[2], const LAS char* vp0, const f32x16& P0, const f32x16& P1) {
    bf16x8 vf[8]; pv_load(vf, vp0); __builtin_amdgcn_sched_barrier(0); pv_mma(o, vf, P0, P1);
}
__device__ __forceinline__ void store_o(const f32x16 (&o)[2], const float (&rsc)[16], LAS char* stgc, bf16_t* Ow  , int pitch, int lane, int r32, int hi) {
    LAS bf16_t* stg = (LAS bf16_t*)stgc;
#pragma unroll
    for (int r = 0; r < 16; ++r) { const int orow = crow(r, hi);
#pragma unroll
        for (int d0 = 0; d0 < 2; ++d0) stg[orow * 64 + d0 * 32 + r32] = (bf16_t)f2bf(o[d0][r] * rsc[r]); }
    LDS_WAIT();
#pragma unroll
    for (int i = 0; i < 4; ++i) { const int row = i * 8 + (lane >> 3), ch = lane & 7; const u32x4 v = *(const LAS u32x4*)(stg + row * 64 + ch * 8); st16_wt(Ow + (size_t)row * pitch + ch * 8, v); }
    LDS_WAIT();
}

constexpr int WL_V = 0, WL_O = 0, WL_F = 16384, WL_STRIDE = 16640;
static_assert(8 * WL_STRIDE <= LDSCTL_OFF, "per-wave attention scratch");

template <bool diag> __device__ __forceinline__ void sb_tile_math_t(f32x16& z0, f32x16& z1, float& carry, int s0, int tq, int hi) {
        f32x16 q0, q1;
#pragma unroll
        for (int r = 0; r < 16; ++r) {
            const int kv = s0 + crow(r, hi);
            { float q = __builtin_amdgcn_rcpf(1.0f + __builtin_amdgcn_exp2f(z0[r])); if (diag && !(kv < tq)) q = 1.f; q0[r] = q; }
            { float q = __builtin_amdgcn_rcpf(1.0f + __builtin_amdgcn_exp2f(z1[r])); if (diag && !(kv + 32 < tq)) q = 1.f; q1[r] = q; }
        }
        float own[8], oth[8], S[8];
#pragma unroll
        for (int G = 0; G < 4; ++G) { own[G] = (q0[4 * G] * q0[4 * G + 1]) * (q0[4 * G + 2] * q0[4 * G + 3]); own[4 + G] = (q1[4 * G] * q1[4 * G + 1]) * (q1[4 * G + 2] * q1[4 * G + 3]); }
#pragma unroll
        for (int i = 0; i < 8; ++i) { const auto rr = __builtin_amdgcn_permlane32_swap(__float_as_uint(own[i]), __float_as_uint(own[i]), false, false);
            own[i] = __uint_as_float(rr[0]) * __uint_as_float(rr[1]); oth[i] = __uint_as_float(rr[1]); }
        float run = 1.f;
#pragma unroll
        for (int i = 7; i >= 0; --i) { S[i] = run; run *= own[i]; }
#pragma unroll
        for (int i = 0; i < 8; ++i) {
            float after = carry * S[i] * (hi == 0 ? oth[i] : 1.f);
#pragma unroll
            for (int e = 3; e >= 0; --e) {
                const int r = 4 * (i & 3) + e;
                if (i < 4) { const float nx = after * q0[r]; z0[r] = after - nx; after = nx; }
                else       { const float nx = after * q1[r]; z1[r] = after - nx; after = nx; }
            }
        }
        carry *= run;
}
__device__ __forceinline__ void sb_tile_math(f32x16& z0, f32x16& z1, float& carry, bool diag, int s0, int tq, int hi) {
    if (diag) sb_tile_math_t<true>(z0, z1, carry, s0, tq, hi); else sb_tile_math_t<false>(z0, z1, carry, s0, tq, hi);
}

__device__ __forceinline__ void sb_unit(int b, int h, int qb, const bf16_t* Q, const bf16_t* K, const bf16_t* V, bf16_t* O, LAS char* wl, int lane, bool dry) {
    const int r32 = lane & 31, hi = lane >> 5; const int t0 = qb * 32; const size_t rowbase = (size_t)b * T;
    const bf16_t* Qw = Q + (rowbase + t0) * D + h * 64; const bf16_t* Kh = K + rowbase * D + h * 64; const bf16_t* Vh = V + rowbase * D + h * 64;
    bf16x8 qr[4];
#pragma unroll
    for (int d0 = 0; d0 < 4; ++d0) qr[d0] = *(const bf16x8*)(Qw + (size_t)r32 * D + 16 * d0 + 8 * hi);
    f32x16 o[2]; o[0] = f32x16{}; o[1] = f32x16{};
    float carry = 1.f; const int tq = t0 + r32; const int jd = t0 >> 6;
    const LAS char* vp0 = wl + WL_V + ((lane >> 4) & 1) * 32 + (lane & 3) * 8 + (4 * hi + ((lane & 15) >> 2)) * 64;
    bf16x8 kf[8];
    load_kfrag(kf, Kh + (size_t)jd * 64 * D, D, r32, hi);
    dma_vtile(Vh + (size_t)jd * 64 * D, D, lane, wl + WL_V);
    int slot = 0;
    for (int j = jd; j >= 0; --j) {
        const int s0 = j * 64;
        VM_WAIT();
        if (j > 0) dma_vtile(Vh + (size_t)(s0 - 64) * D, D, lane, wl + WL_V + (slot ^ 8192));
        f32x16 z0, z1; qkt(z0, z1, kf, qr);
        if (j > 0) load_kfrag(kf, Kh + (size_t)(s0 - 64) * D, D, r32, hi);
        sb_tile_math(z0, z1, carry, j == jd, s0, tq, hi);
        pv(o, vp0 + slot, z0, z1);
        if (__builtin_amdgcn_ballot_w64(carry != 0.f) == 0ull) break;
        LDS_WAIT();
        slot ^= 8192;
    }
    VM_WAIT(); LDS_WAIT();
    float one[16];
#pragma unroll
    for (int r = 0; r < 16; ++r) one[r] = 1.f;
    if (!dry) store_o(o, one, wl + WL_O, O + (rowbase + t0) * D + h * 64, D, lane, r32, hi);
}

constexpr int SL_SLOT = 32768, SL_HEAD = 16384, SL_VOFF = 8192, SL_O = 98304, SL_FLAG = 131072;
static_assert(SL_FLAG + 64 <= LDSCTL_OFF, "stick-breaking LDS");
__device__ __forceinline__ void sb_prefetch(bf16x8 (&qr)[4], int b, int hp, int u, const bf16_t* Q, const bf16_t* K, const bf16_t* V, LAS char* L, int wid, int lane) {
    const int r32 = lane & 31, hi = lane >> 5; const int hh = wid >> 2, qw = wid & 3, h = 2 * hp + hh;
    const int t0 = 128 * u + 32 * qw; const size_t rowbase = (size_t)b * T; const int jtop = 2 * u + 1;
    const bf16_t* Qw = Q + (rowbase + t0) * D + h * 64; const bf16_t* Kh = K + rowbase * D + h * 64; const bf16_t* Vh = V + rowbase * D + h * 64;
    const unsigned kvoff = (unsigned)lane * 2048u, vvoff = (unsigned)((lane >> 2) * D + (lane & 3) * 8) * 2u;
    const int pa = 2 * qw, pb = 2 * qw + 1;
    const bf16_t* Kwa = Kh + pa * 8; const bf16_t* Kwb = Kh + pb * 8;
    const bf16_t* Vwa = Vh + (size_t)(16 * (pa & 3)) * D + (pa >> 2) * 32; const bf16_t* Vwb = Vh + (size_t)(16 * (pb & 3)) * D + (pb >> 2) * 32;
    const unsigned hbase = (unsigned)(size_t)L + hh * SL_HEAD;
    const unsigned kda = hbase + pa * 1024u, kdb = hbase + pb * 1024u, vda = hbase + SL_VOFF + pa * 1024u, vdb = hbase + SL_VOFF + pb * 1024u;
#pragma unroll
    for (int k = 0; k < 2; ++k) { const size_t ro_ = (size_t)(jtop - k) * 64 * D; const unsigned so_ = (unsigned)(k * SL_SLOT);
        glds16_s(Kwa + ro_, kvoff, kda + so_); glds16_s(Kwb + ro_, kvoff, kdb + so_); glds16_s(Vwa + ro_, vvoff, vda + so_); glds16_s(Vwb + ro_, vvoff, vdb + so_); }
#pragma unroll
    for (int d0 = 0; d0 < 4; ++d0) qr[d0] = *(const bf16x8*)(Qw + (size_t)r32 * D + 16 * d0 + 8 * hi);
}
__device__ __forceinline__ void sb_block_unit(bf16x8 (&qr)[4], int b, int hp  , int u  , int nb, int nhp, int nu, const bf16_t* Q, const bf16_t* K, const bf16_t* V, bf16_t* O, LAS char* L, int wid, int lane) {
    const int r32 = lane & 31, hi = lane >> 5; const int hh = wid >> 2, qw = wid & 3, h = 2 * hp + hh;
    const int t0 = 128 * u + 32 * qw; const size_t rowbase = (size_t)b * T; const int jtop = 2 * u + 1, jdw = t0 >> 6; const int tq = t0 + r32;
    const bf16_t* Kh = K + rowbase * D + h * 64; const bf16_t* Vh = V + rowbase * D + h * 64;
    const unsigned kvoff = (unsigned)lane * 2048u;
    const unsigned vvoff = (unsigned)((lane >> 2) * D + (lane & 3) * 8) * 2u;
    const int pa = 2 * qw, pb = 2 * qw + 1;
    const bf16_t* Kwa = Kh + pa * 8; const bf16_t* Kwb = Kh + pb * 8;
    const bf16_t* Vwa = Vh + (size_t)(16 * (pa & 3)) * D + (pa >> 2) * 32; const bf16_t* Vwb = Vh + (size_t)(16 * (pb & 3)) * D + (pb >> 2) * 32;
    const unsigned hbase = (unsigned)(size_t)L + hh * SL_HEAD;
    const unsigned kda = hbase + pa * 1024u, kdb = hbase + pb * 1024u, vda = hbase + SL_VOFF + pa * 1024u, vdb = hbase + SL_VOFF + pb * 1024u;
    const LAS char* kp0 = L + hh * SL_HEAD + hi * 1024 + r32 * 16;
    const LAS char* vp0 = L + hh * SL_HEAD + SL_VOFF + ((lane >> 4) & 1) * 32 + (lane & 3) * 8 + (4 * hi + ((lane & 15) >> 2)) * 64;
    LAS unsigned* flags = (LAS unsigned*)(L + SL_FLAG);
    if (lane == 0) flags[wid] = 0u;
#define SB_STAGE(j_, so_) do { const size_t ro_ = (size_t)(j_) * 64 * D; glds16_s(Kwa + ro_, kvoff, kda + (so_)); glds16_s(Kwb + ro_, kvoff, kdb + (so_)); glds16_s(Vwa + ro_, vvoff, vda + (so_)); glds16_s(Vwb + ro_, vvoff, vdb + (so_)); } while (0)
    f32x16 o[2]; o[0] = f32x16{}; o[1] = f32x16{};
    float carry = 1.f; bool gone = false;
    asm volatile("s_waitcnt vmcnt(0) lgkmcnt(0)\n\ts_barrier" ::: "memory");
    int sc = 0, sn = SL_SLOT, sn2 = 2 * SL_SLOT;
    for (int j = jtop; j >= 0; --j) {
        if (j >= 2) SB_STAGE(j - 2, (unsigned)sn2);
        if (j <= jdw && !gone) {
            bf16x8 kf[8];
#pragma unroll
            for (int d0 = 0; d0 < 4; ++d0) { kf[2 * d0] = *(const LAS bf16x8*)(kp0 + sc + d0 * 2048); kf[2 * d0 + 1] = *(const LAS bf16x8*)(kp0 + sc + d0 * 2048 + 512); }
            __builtin_amdgcn_sched_barrier(0);
            f32x16 z0, z1; qkt(z0, z1, kf, qr);
            bf16x8 vf[8]; pv_load(vf, vp0 + sc);
            __builtin_amdgcn_sched_barrier(0);
            sb_tile_math(z0, z1, carry, j == jdw, j * 64, tq, hi);
            pv_mma(o, vf, z0, z1);
            if (__builtin_amdgcn_ballot_w64(carry != 0.f) == 0ull) { gone = true; if (lane == 0) flags[wid] = 1u; }
        }
        if (j >= 2) asm volatile("s_waitcnt vmcnt(4) lgkmcnt(0)\n\ts_barrier" ::: "memory");
        else asm volatile("s_waitcnt vmcnt(0) lgkmcnt(0)\n\ts_barrier" ::: "memory");
        { const u32x4 f0 = *(const LAS u32x4*)flags, f1 = *(const LAS u32x4*)(flags + 4);
          if ((f0[0] & f0[1] & f0[2] & f0[3] & f1[0] & f1[1] & f1[2] & f1[3]) != 0u) break; }
        { const int t_ = sc; sc = sn; sn = sn2; sn2 = t_; }
    }
#undef SB_STAGE
    asm volatile("s_waitcnt vmcnt(0)" ::: "memory");
    if (nb >= 0) sb_prefetch(qr, nb, nhp, nu, Q, K, V, L, wid, lane);
    float one[16];
#pragma unroll
    for (int r = 0; r < 16; ++r) one[r] = 1.f;
    store_o(o, one, L + SL_O + wid * 4096, O + (rowbase + t0) * D + h * 64, D, lane, r32, hi);
    asm volatile("s_waitcnt lgkmcnt(0)\n\ts_barrier" ::: "memory");
}

__device__ __forceinline__ void dsa_unit(int b, int h, int qb, const bf16_t* Q, const bf16_t* K, const bf16_t* V, const unsigned long long* mask, bf16_t* O, LAS char* wl, int lane) {
    const int r32 = lane & 31, hi = lane >> 5; const int t0 = qb * 32; const size_t rowbase = (size_t)b * T; const int kvh = h >> 2;
    const bf16_t* Qw = Q + (rowbase + t0) * 512 + h * 64; const bf16_t* Kh = K + rowbase * 128 + kvh * 64; const bf16_t* Vh = V + rowbase * 128 + kvh * 64;
    const unsigned long long* mrow = mask + (rowbase + t0 + r32) * 64;
    bf16x8 qr[4];
#pragma unroll
    for (int d0 = 0; d0 < 4; ++d0) qr[d0] = *(const bf16x8*)(Qw + (size_t)r32 * 512 + 16 * d0 + 8 * hi);
    f32x16 o[2]; o[0] = f32x16{}; o[1] = f32x16{};
    float mrun = -1e30f, lsum = 0.f; const int jd = t0 >> 6;
    LAS float* wsf = (LAS float*)(wl + WL_F);
    const LAS char* vp0 = wl + WL_V + ((lane >> 4) & 1) * 32 + (lane & 3) * 8 + (4 * hi + ((lane & 15) >> 2)) * 64;
    bf16x8 kf[8];
    load_kfrag(kf, Kh, 128, r32, hi);
    dma_vtile(Vh, 128, lane, wl + WL_V);
    unsigned long long mw = mrow[0]; int slot = 0;
    for (int j = 0; j <= jd; ++j) {
        const int s0 = j * 64;
        VM_WAIT();
        if (j < jd) dma_vtile(Vh + (size_t)(s0 + 64) * 128, 128, lane, wl + WL_V + (slot ^ 8192));
        f32x16 p0, p1; qkt(p0, p1, kf, qr);
        if (j < jd) load_kfrag(kf, Kh + (size_t)(s0 + 64) * 128, 128, r32, hi);
        const unsigned long long mwn = (j < jd) ? mrow[j + 1] : 0ull;
        const unsigned mlo = (unsigned)mw >> (4 * hi), mhi = (unsigned)(mw >> 32) >> (4 * hi);
        float rm = -INFINITY;
#pragma unroll
        for (int r = 0; r < 16; ++r) { const int bit = (r & 3) + 8 * (r >> 2);
            if (!((mlo >> bit) & 1u)) p0[r] = -INFINITY; if (!((mhi >> bit) & 1u)) p1[r] = -INFINITY;
            rm = __builtin_fmaxf(rm, __builtin_fmaxf(p0[r], p1[r])); }
        rm = __builtin_fmaxf(rm, swap_other(rm, hi));
        const float mnew = __builtin_fmaxf(mrun, rm);
        const float alpha = __builtin_amdgcn_exp2f(mrun - mnew);
        float ps = 0.f;
#pragma unroll
        for (int r = 0; r < 16; ++r) { p0[r] = __builtin_amdgcn_exp2f(p0[r] - mnew); p1[r] = __builtin_amdgcn_exp2f(p1[r] - mnew); ps += p0[r] + p1[r]; }
        lsum = lsum * alpha + ps;
        if (__builtin_amdgcn_ballot_w64(mnew > mrun) != 0ull) {
            if (hi == 0) wsf[r32] = alpha;
            LDS_WAIT();
#pragma unroll
            for (int r = 0; r < 16; ++r) { const float f = wsf[crow(r, hi)]; o[0][r] *= f; o[1][r] *= f; }
        }
        mrun = mnew;
        LDS_WAIT();
        pv(o, vp0 + slot, p0, p1);
        LDS_WAIT();
        slot ^= 8192; mw = mwn;
    }
    VM_WAIT();
    lsum += swap_other(lsum, hi);
    if (hi == 0) wsf[32 + r32] = lsum;
    LDS_WAIT();
    float rli[16];
#pragma unroll
    for (int r = 0; r < 16; ++r) rli[r] = 1.0f / wsf[32 + crow(r, hi)];
    store_o(o, rli, wl + WL_O, O + (rowbase + t0) * D + h * 64, D, lane, r32, hi);
}

constexpr int IL_QF = 103424;
constexpr int DL_K = 0, DL_V = 24576, DL_O = 49152, DL_F = 81920, DL_T = 83968;
constexpr float DSA_THR = 8.0f;
__device__ __forceinline__ float max3f(float a, float b, float c) { float r; asm("v_max3_f32 %0, %1, %2, %3" : "=v"(r) : "v"(a), "v"(b), "v"(c)); return r; }
__device__ __forceinline__ float dsa_cinit(unsigned word, int bit, unsigned negm) {
    unsigned m, c; asm("v_bfe_i32 %0, %1, %2, 1" : "=v"(m) : "v"(word), "n"(bit)); asm("v_bfi_b32 %0, %1, %2, %3" : "=v"(c) : "v"(m), "v"(negm), "v"(0xFF800000u)); return __uint_as_float(c);
}
__device__ __forceinline__ void dsa_qk(f32x16& p0, f32x16& p1, const LAS char* kp, const bf16x8 (&qr)[4], unsigned long long mw, int hi, float mref, const LAS char* tbl) {
    bf16x8 kf[8];
#pragma unroll
    for (int d0 = 0; d0 < 4; ++d0) { kf[2 * d0] = *(const LAS bf16x8*)(kp + d0 * 2048); kf[2 * d0 + 1] = *(const LAS bf16x8*)(kp + d0 * 2048 + 512); }
    const unsigned mlo = (unsigned)mw >> (4 * hi), mhi = (unsigned)(mw >> 32) >> (4 * hi), negm = __float_as_uint(-mref);
    if (tbl) {
#pragma unroll
        for (int i = 0; i < 4; ++i) { const u32x4 a = *(const LAS u32x4*)(tbl + ((mlo >> (8 * i)) & 15u) * 16u), b = *(const LAS u32x4*)(tbl + ((mhi >> (8 * i)) & 15u) * 16u);
#pragma unroll
            for (int e = 0; e < 4; ++e) { p0[4 * i + e] = __uint_as_float(a[e]); p1[4 * i + e] = __uint_as_float(b[e]); } }
        __builtin_amdgcn_sched_barrier(0);
    } else {
        __builtin_amdgcn_sched_barrier(0);
#pragma unroll
        for (int r = 0; r < 16; ++r) { p0[r] = dsa_cinit(mlo, (r & 3) + 8 * (r >> 2), negm); p1[r] = dsa_cinit(mhi, (r & 3) + 8 * (r >> 2), negm); }
        __builtin_amdgcn_sched_barrier(0);
    }
#pragma unroll
    for (int d0 = 0; d0 < 4; ++d0) {
        p0 = __builtin_amdgcn_mfma_f32_32x32x16_bf16(kf[2 * d0], qr[d0], p0, 0, 0, 0);
        p1 = __builtin_amdgcn_mfma_f32_32x32x16_bf16(kf[2 * d0 + 1], qr[d0], p1, 0, 0, 0);
    }
}
__device__ __forceinline__ void dsa_step(f32x16& c0, f32x16& c1, f32x16& n0, f32x16& n1, const bool have_n, const LAS char* kpn, const LAS char* vpc, const bf16x8 (&qr)[4], unsigned long long mwn,
                                         f32x16 (&o)[2], float& mref, float& lsum, LAS float* wsf, int r32, int hi, const bool fixed, const LAS char* tblp) {
    if (have_n) dsa_qk(n0, n1, kpn, qr, mwn, hi, mref, fixed ? tblp : (const LAS char*)nullptr);
    bf16x8 vf[8]; pv_load(vf, vpc);
    __builtin_amdgcn_sched_barrier(0);
    bool resc = false; float rm = 0.f;
    if (!fixed) {
        rm = __builtin_fmaxf(c0[0], c1[0]);
#pragma unroll
        for (int r = 1; r < 16; ++r) rm = max3f(rm, c0[r], c1[r]);
        rm = __builtin_fmaxf(rm, swap_other(rm, hi));
        resc = __builtin_amdgcn_ballot_w64(rm > DSA_THR) != 0ull;
    }
    if (resc) { const float dl = __builtin_fmaxf(rm, 0.f); mref += dl; const float f = __builtin_amdgcn_exp2f(-dl); lsum *= f; if (hi == 0) wsf[r32] = f;
#pragma unroll
        for (int r = 0; r < 16; ++r) { c0[r] -= dl; c1[r] -= dl; }
        if (have_n) {
#pragma unroll
            for (int r = 0; r < 16; ++r) { n0[r] -= dl; n1[r] -= dl; } } }
    f32x2 ps2 = {0.f, 0.f};
#pragma unroll
    for (int r = 0; r < 16; r += 2) { c0[r] = __builtin_amdgcn_exp2f(c0[r]); c0[r + 1] = __builtin_amdgcn_exp2f(c0[r + 1]); c1[r] = __builtin_amdgcn_exp2f(c1[r]); c1[r + 1] = __builtin_amdgcn_exp2f(c1[r + 1]);
        ps2 += (f32x2){c0[r], c0[r + 1]}; ps2 += (f32x2){c1[r], c1[r + 1]}; }
    lsum += ps2[0] + ps2[1];
    if (resc) { LDS_WAIT();
#pragma unroll
        for (int r = 0; r < 16; ++r) { const float f = wsf[crow(r, hi)]; o[0][r] *= f; o[1][r] *= f; } }
    pv_mma(o, vf, c0, c1);
    asm volatile("s_waitcnt vmcnt(0) lgkmcnt(0)\n\ts_barrier" ::: "memory");
}
__device__ __forceinline__ void dsa_block_unit(int b, int g, int m  , const bf16_t* Q, const bf16_t* K, const bf16_t* V, const unsigned long long* mask, bf16_t* O, LAS char* L, int wid, int lane, float sbound  ) {
    const int r32 = lane & 31, hi = lane >> 5; const int h = 4 * g + (wid & 3), t0 = 64 * m + 32 * (wid >> 2); const size_t rowbase = (size_t)b * T; const int jd = m;
    const bf16_t* Qw = Q + (rowbase + t0) * 512 + h * 64; const bf16_t* Kg = K + rowbase * 128 + g * 64; const bf16_t* Vg = V + rowbase * 128 + g * 64;
    const unsigned long long* mrow = mask + (rowbase + t0 + r32) * 64;
    bf16x8 qr[4];
#pragma unroll
    for (int d0 = 0; d0 < 4; ++d0) qr[d0] = *(const bf16x8*)(Qw + (size_t)r32 * 512 + 16 * d0 + 8 * hi);
    f32x16 o[2]; o[0] = f32x16{}; o[1] = f32x16{};
    const bool fixed = sbound > 0.f;
    float mref = fixed ? sbound : 0.f, lsum = 0.f;
    LAS float* wsf = (LAS float*)(L + DL_F + wid * 256);
    const unsigned kvoff = (unsigned)lane * 256u;
    const unsigned vvoff = (unsigned)((lane >> 2) * 128 + (lane & 3) * 8) * 2u;
    const bf16_t* Kw = Kg + wid * 8; const bf16_t* Vw = Vg + (size_t)(16 * (wid & 3)) * 128 + (wid >> 2) * 32;
    const unsigned kdst = (unsigned)(size_t)(L + DL_K) + wid * 1024u, vdst = (unsigned)(size_t)(L + DL_V) + wid * 1024u;
    const LAS char* kp0 = L + DL_K + hi * 1024 + r32 * 16;
    const LAS char* vp0 = L + DL_V + ((lane >> 4) & 1) * 32 + (lane & 3) * 8 + (4 * hi + ((lane & 15) >> 2)) * 64;
    glds16_s(Kw, kvoff, kdst); glds16_s(Vw, vvoff, vdst);
    if (jd >= 1) { glds16_s(Kw + (size_t)64 * 128, kvoff, kdst + 8192); glds16_s(Vw + (size_t)64 * 128, vvoff, vdst + 8192); }
    unsigned long long mwn = mrow[0];
    unsigned long long mwn2 = (jd >= 1) ? mrow[1] : 0ull;
    asm volatile("s_waitcnt vmcnt(0) lgkmcnt(0)\n\ts_barrier" ::: "memory");
    const LAS char* tblp = L + DL_T;
    f32x16 pa0, pa1, pb0, pb1; dsa_qk(pa0, pa1, kp0, qr, mwn, hi, mref, fixed ? tblp : (const LAS char*)nullptr);
    mwn = mwn2;
    int sc = 0, sn = 8192, sn2 = 16384;
    for (int j = 0; j <= jd; j += 2) {
        if (j + 2 <= jd) { glds16_s(Kw + (size_t)(j + 2) * 64 * 128, kvoff, kdst + sn2); glds16_s(Vw + (size_t)(j + 2) * 64 * 128, vvoff, vdst + sn2); mwn2 = mrow[j + 2]; }
        dsa_step(pa0, pa1, pb0, pb1, j < jd, kp0 + sn, vp0 + sc, qr, mwn, o, mref, lsum, wsf, r32, hi, fixed, tblp);
        if (j == jd) break;
        { const int t_ = sc; sc = sn; sn = sn2; sn2 = t_; } mwn = mwn2;
        if (j + 3 <= jd) { glds16_s(Kw + (size_t)(j + 3) * 64 * 128, kvoff, kdst + sn2); glds16_s(Vw + (size_t)(j + 3) * 64 * 128, vvoff, vdst + sn2); mwn2 = mrow[j + 3]; }
        dsa_step(pb0, pb1, pa0, pa1, j + 1 < jd, kp0 + sn, vp0 + sc, qr, mwn, o, mref, lsum, wsf, r32, hi, fixed, tblp);
        { const int t_ = sc; sc = sn; sn = sn2; sn2 = t_; } mwn = mwn2;
    }
    lsum += swap_other(lsum, hi);
    if (hi == 0) wsf[32 + r32] = lsum;
    LDS_WAIT();
    float rli[16];
#pragma unroll
    for (int r = 0; r < 16; ++r) rli[r] = 1.0f / wsf[32 + crow(r, hi)];
    store_o(o, rli, L + DL_O + wid * 4096, O + (rowbase + t0) * D + h * 64, D, lane, r32, hi);
}

__device__ __forceinline__ unsigned fkey(float v) { unsigned u = __float_as_uint(v); if (u == 0x80000000u) u = 0u; return (u & 0x80000000u) ? ~u : (u | 0x80000000u); }
__device__ __forceinline__ void idx_scores_half(f32x16& sc, const bf16_t* KIt  , const LAS char* QF, const f32x4& w, int r32, int hi) {
    bf16x8 kf[4];
#pragma unroll
    for (int d0 = 0; d0 < 4; ++d0) kf[d0] = *(const bf16x8*)(KIt + (size_t)r32 * 64 + 16 * d0 + 8 * hi);
    sc = f32x16{};
#pragma unroll
    for (int h = 0; h < 4; ++h) { f32x16 p = f32x16{};
#pragma unroll
        for (int d0 = 0; d0 < 4; ++d0) p = __builtin_amdgcn_mfma_f32_32x32x16_bf16(kf[d0], *(const LAS bf16x8*)(QF + ((h * 4 + d0) * 2 + hi) * 512 + r32 * 16), p, 0, 0, 0);
#pragma unroll
        for (int r = 0; r < 16; ++r) sc[r] = fmaf(w[h], __builtin_fmaxf(p[r], 0.f), sc[r]); }
}
__device__ __forceinline__ void idx_unit(int b, int qb, const bf16_t* QI, const bf16_t* KI, const float* WI, unsigned long long* mask, LAS unsigned* hist, int tid) {
    const int lane = tid & 63, wid = __builtin_amdgcn_readfirstlane(tid >> 6), r32 = lane & 31, hi = lane >> 5;
    const int t0 = qb * 32, jd = t0 >> 6, jtop = 4 * (t0 >> 8) + 3; const size_t rowbase = (size_t)b * T; const int tq = t0 + r32;
    const size_t row = rowbase + tq;
    const LAS char* qf = (const LAS char*)hist + IL_QF;
    const f32x4 w = *(const f32x4*)(WI + row * 4);
    const bf16_t* KIb = KI + rowbase * 64;
    unsigned base = 0u, need = 256u, sthr = 4095u, jt = 0u; bool done = (t0 < 256);
    if (t0 >= 256) {
        for (int i = tid; i < 2 * 32 * 65; i += 512) hist[i] = 0u;
        __syncthreads();
        for (int stage = 0; stage < 8; ++stage) {
            LAS unsigned* HB = hist + (stage & 1) * (32 * 65);
            const int shift = stage < 5 ? 26 - 6 * stage : (stage == 5 ? 0 : (stage == 6 ? 6 : 0));
            const unsigned bmask = (stage == 5) ? 3u : 63u;
            const unsigned xmask = stage == 0 ? 0u : (stage < 6 ? (0xFFFFFFFFu << (shift + (stage == 5 ? 2 : 6))) : 0xFFFFFFFFu);
            for (int j = wid; j <= jd; j += 8) {
                const bool diag = (j == jd);
#pragma unroll 1
                for (int p = 0; p < 2; ++p) {
                    f32x16 sc; idx_scores_half(sc, KIb + (size_t)(j * 64 + 32 * p) * 64, qf, w, r32, hi);
#pragma unroll
                    for (int r = 0; r < 16; ++r) {
                        const int s = j * 64 + 32 * p + crow(r, hi); const unsigned key = fkey(sc[r]);
                        bool in = !done && (!diag || s <= tq) && (((key ^ base) & xmask) == 0u);
                        if (stage == 7) in = in && ((unsigned)j == jt);
                        const unsigned src = stage < 6 ? key : (unsigned)s;
                        const unsigned bin = (src >> shift) & bmask;
                        if (in) __hip_atomic_fetch_add(&HB[r32 * 65 + bin], 1u, __ATOMIC_RELAXED, __HIP_MEMORY_SCOPE_WORKGROUP);
                    }
                }
            }
            __syncthreads();
            if (!done) {
                const int nb = (stage == 5) ? 4 : 64; const bool desc = stage < 6;
                unsigned cum = 0u, tb = 0u, before = 0u, ctb = 0u; bool found = false;
                for (int i = 0; i < nb; ++i) { const int bidx = desc ? nb - 1 - i : i; const unsigned c = HB[r32 * 65 + bidx];
                    if (!found && cum + c >= need) { found = true; tb = (unsigned)bidx; before = cum; ctb = c; }
                    cum += c; }
                if (!found) { tb = desc ? 0u : (unsigned)(nb - 1); before = 0u; ctb = need; }
                need -= before;
                if (stage < 6) { base |= tb << shift; if (need == ctb) done = true; }
                else if (stage == 6) { jt = tb; }
                else { sthr = 64u * jt + tb; done = true; }
            }
            { LAS unsigned* HN = hist + ((stage + 1) & 1) * (32 * 65); for (int i = tid; i < 32 * 65; i += 512) HN[i] = 0u; }
            __syncthreads();
            if (__builtin_amdgcn_ballot_w64(!done) == 0ull) break;
        }
    }
    for (int j = wid; j <= jtop; j += 8) {
        unsigned lo = 0u, hw = 0u;
        if (j <= jd) {
            const bool diag = (j == jd);
#pragma unroll 1
            for (int p = 0; p < 2; ++p) {
                f32x16 sc; idx_scores_half(sc, KIb + (size_t)(j * 64 + 32 * p) * 64, qf, w, r32, hi);
                unsigned bits = 0u;
#pragma unroll
                for (int r = 0; r < 16; ++r) {
                    const int s = j * 64 + 32 * p + crow(r, hi); const unsigned key = fkey(sc[r]);
                    const bool sel = (!diag || s <= tq) && (key > base || (key == base && (unsigned)s <= sthr));
                    if (sel) bits |= 1u << crow(r, 0);
                }
                bits <<= 4 * hi;
                if (p) hw = bits; else lo = bits;
            }
        }
        lo = swap_or(lo); hw = swap_or(hw);
        if (hi == 0) mask[row * 64 + j] = (unsigned long long)lo | ((unsigned long long)hw << 32);
    }
    __syncthreads();
}

constexpr int IDX_CAP = 192, ZBIN = 160, NBINS = 320, HSTR = 321;
constexpr int IL_CNT = 0, IL_TABN = 128, IL_TABNEED = 256, IL_TABBIN = 384, IL_CAND = 512, IL_HIST = IL_CAND, IL_MASK = IL_CAND + 32 * IDX_CAP * 8, IL_Z = IL_MASK + 32 * 64 * 8, IL_END = IL_Z + 32 * 64 * 8;
static_assert(IL_QF >= IL_END && IL_QF + 16384 <= RING_BYTES, "indexer LDS (qf)");
static_assert(32 * HSTR * 4 <= 32 * IDX_CAP * 8 && (32 * HSTR * 4) % 16 == 0 && IL_END <= RING_BYTES, "indexer LDS");
__device__ __forceinline__ unsigned fkey2(float v) { const unsigned u = __float_as_uint(v + 0.0f); return u ^ ((unsigned)((int)u >> 31) | 0x80000000u); }
__device__ __forceinline__ int imed3(int a, int lo, int hi) { const int x = a > hi ? hi : a; return x < lo ? lo : x; }
__device__ __forceinline__ int ibin_u(unsigned u) {
    const int a = (int)u >> 20;
    return imed3(-953 - a, 0, 159) + imed3(a - 936, 0, 158) + imed3((int)u, -160, 1) + 160;
}
__device__ __forceinline__ int ibin_u_m160(unsigned u) {
    const int a = (int)u >> 20;
    return imed3(-953 - a, 0, 159) + imed3(a - 936, 0, 158) + imed3((int)u, -160, 1);
}
__device__ __forceinline__ unsigned keylo(int b) {
    return b <= 0 ? 0u : (b <= 159 ? (unsigned)(b + 952) << 20 : (b == 160 ? 0x80000000u : (b == 161 ? 0x80000001u : (b <= 319 ? (0x80000000u | ((unsigned)(b + 775) << 20)) : 0xFFFFFFFFu))));
}
__device__ __forceinline__ float relu_i(float p) { const int i = __float_as_int(p); return __int_as_float(i > 0 ? i : 0); }
__device__ __forceinline__ void shl_ge(unsigned& acc, unsigned key, unsigned thr) { asm("v_cmp_ge_u32 vcc, %1, %2\n\tv_addc_co_u32 %0, vcc, %0, %0, vcc" : "+v"(acc) : "v"(key), "v"(thr) : "vcc"); }
__device__ __forceinline__ unsigned spread4(unsigned x) { return (x & 0xFu) | ((x & 0xF0u) << 4) | ((x & 0xF00u) << 8) | ((x & 0xF000u) << 12); }
__device__ __forceinline__ void idx_loadk(bf16x8 (&kf)[4], const bf16_t* KIt, int r32, int hi) {
#pragma unroll
    for (int d0 = 0; d0 < 4; ++d0) kf[d0] = *(const bf16x8*)(KIt + (size_t)r32 * 64 + 16 * d0 + 8 * hi);
}
__device__ __forceinline__ void idx_scores_k(f32x16& sc, const bf16x8 (&kf)[4], const bf16x8 (&qf)[16], const f32x4& w) {
    f32x16 p0 = f32x16{}, p1 = f32x16{};
#pragma unroll
    for (int d0 = 0; d0 < 4; ++d0) p0 = __builtin_amdgcn_mfma_f32_32x32x16_bf16(kf[d0], qf[d0], p0, 0, 0, 0);
#pragma unroll
    for (int d0 = 0; d0 < 4; ++d0) p1 = __builtin_amdgcn_mfma_f32_32x32x16_bf16(kf[d0], qf[4 + d0], p1, 0, 0, 0);
#pragma unroll
    for (int r = 0; r < 16; ++r) sc[r] = w[0] * relu_i(p0[r]);
    p0 = f32x16{};
#pragma unroll
    for (int d0 = 0; d0 < 4; ++d0) p0 = __builtin_amdgcn_mfma_f32_32x32x16_bf16(kf[d0], qf[8 + d0], p0, 0, 0, 0);
#pragma unroll
    for (int r = 0; r < 16; ++r) sc[r] = fmaf(w[1], relu_i(p1[r]), sc[r]);
    p1 = f32x16{};
#pragma unroll
    for (int d0 = 0; d0 < 4; ++d0) p1 = __builtin_amdgcn_mfma_f32_32x32x16_bf16(kf[d0], qf[12 + d0], p1, 0, 0, 0);
#pragma unroll
    for (int r = 0; r < 16; ++r) sc[r] = fmaf(w[2], relu_i(p0[r]), sc[r]);
#pragma unroll
    for (int r = 0; r < 16; ++r) sc[r] = fmaf(w[3], relu_i(p1[r]), sc[r]);
}
template <int PASS, bool DIAG> __device__ __forceinline__ void idx_half(unsigned& bits, unsigned& ebits, const f32x16& sc, int sbase, int tq, int r32, int hi, unsigned khi, unsigned klo, bool cand, LAS unsigned char* L) {
    bits = 0u; ebits = 0u;
    const int d = tq - sbase - 4 * hi;
    if (PASS == 1) {
        LAS unsigned* H = (LAS unsigned*)(L + IL_HIST) + r32 * HSTR + 160;
#pragma unroll
        for (int r = 0; r < 16; ++r) { int b = ibin_u_m160(__float_as_uint(sc[r] + 0.0f)); asm("" : "+v"(b));
            if (!DIAG || crow(r, 0) <= d) __hip_atomic_fetch_add(H + b, 1u, __ATOMIC_RELAXED, __HIP_MEMORY_SCOPE_WORKGROUP); }
    } else {
        unsigned hb = 0u, lb = 0u;
#pragma unroll
        for (int r = 15; r >= 0; --r) { const unsigned key = fkey2(sc[r]); shl_ge(hb, key, khi); shl_ge(lb, key, klo); }
        bits = spread4(hb); ebits = spread4(lb & ~hb);
        if (DIAG) { const unsigned vm = d < 0 ? 0u : (d >= 31 ? 0xFFFFFFFFu : ((2u << d) - 1u)); bits &= vm; ebits &= vm; }
        if (cand && ebits != 0u) {
            unsigned slot = __hip_atomic_fetch_add((LAS unsigned*)(L + IL_CNT) + r32, (unsigned)__builtin_popcount(ebits), __ATOMIC_RELAXED, __HIP_MEMORY_SCOPE_WORKGROUP);
#pragma unroll
            for (int r = 0; r < 16; ++r) if ((ebits >> crow(r, 0)) & 1u) { const int s = sbase + crow(r, hi);
                if (slot < (unsigned)IDX_CAP) ((LAS unsigned long long*)(L + IL_CAND))[r32 * IDX_CAP + slot] = ((unsigned long long)fkey2(sc[r]) << 16) | (unsigned long long)(0xFFFFu - (unsigned)s);
                ++slot; }
        }
        bits <<= 4 * hi; ebits <<= 4 * hi;
    }
}
template <int PASS> __device__ __forceinline__ void idx_pass(const bf16_t* KIb, const bf16x8 (&qf)[16], const f32x4& w, int jd, int tq, int wid, int r32, int hi, unsigned khi, unsigned klo, bool cand, LAS unsigned char* L) {
    bf16x8 kA[4], kB[4];
    int j = wid;
    if (j <= jd) idx_loadk(kA, KIb + (size_t)(j * 64) * 64, r32, hi);
    for (; j <= jd; j += 8) {
        const bool diag = (j == jd);
        idx_loadk(kB, KIb + (size_t)(j * 64 + 32) * 64, r32, hi);
        f32x16 sc; idx_scores_k(sc, kA, qf, w);
        unsigned lo, elo, hw, ehw;
        if (diag) idx_half<PASS, true>(lo, elo, sc, j * 64, tq, r32, hi, khi, klo, cand, L); else idx_half<PASS, false>(lo, elo, sc, j * 64, tq, r32, hi, khi, klo, cand, L);
        if (j + 8 <= jd) idx_loadk(kA, KIb + (size_t)((j + 8) * 64) * 64, r32, hi);
        idx_scores_k(sc, kB, qf, w);
        if (diag) idx_half<PASS, true>(hw, ehw, sc, j * 64 + 32, tq, r32, hi, khi, klo, cand, L); else idx_half<PASS, false>(hw, ehw, sc, j * 64 + 32, tq, r32, hi, khi, klo, cand, L);
        if (PASS == 2) { lo = swap_or(lo); hw = swap_or(hw); elo = swap_or(elo); ehw = swap_or(ehw);
            if (hi == 0) { ((LAS unsigned long long*)(L + IL_MASK))[r32 * 64 + j] = (unsigned long long)lo | ((unsigned long long)hw << 32);
                           ((LAS unsigned long long*)(L + IL_Z))[r32 * 64 + j] = (unsigned long long)elo | ((unsigned long long)ehw << 32); } }
    }
}
template <int NC> __device__ __forceinline__ void idx_rank(LAS unsigned long long* cc, int n, unsigned nd, int lane, LAS unsigned* mrow) {
    const int n8 = (n + 7) & ~7;
    if (lane < 7 && n + lane < n8) { unsigned z; asm volatile("v_mov_b32 %0, 0" : "=v"(z)); ((LAS unsigned*)cc)[2 * (n + lane)] = z; ((LAS unsigned*)cc)[2 * (n + lane) + 1] = z; }
    LDS_WAIT();
    unsigned long long me[NC]; unsigned rank[NC];
#pragma unroll
    for (int k = 0; k < NC; ++k) { me[k] = (lane + 64 * k < n) ? cc[lane + 64 * k] : ~0ull; rank[k] = 0u; }
#pragma unroll 2
    for (int c2 = 0; c2 < n8; c2 += 8) {
        unsigned long long a[8];
#pragma unroll
        for (int i = 0; i < 8; ++i) a[i] = cc[c2 + i];
#pragma unroll
        for (int i = 0; i < 8; ++i)
#pragma unroll
            for (int k = 0; k < NC; ++k) rank[k] += (a[i] > me[k]) ? 1u : 0u;
    }
#pragma unroll
    for (int k = 0; k < NC; ++k) if (lane + 64 * k < n && rank[k] < nd) { const unsigned sI = 0xFFFFu - (unsigned)(me[k] & 0xFFFFull);
        __hip_atomic_fetch_or(mrow + (sI >> 5), 1u << (sI & 31), __ATOMIC_RELAXED, __HIP_MEMORY_SCOPE_WORKGROUP); }
}
__device__ __forceinline__ bool idx_unit_fast(int b, int qb, const bf16_t* QI, const bf16_t* KI, const float* WI, unsigned long long* mask, LAS unsigned char* L, int tid) {
    asm volatile("" : "+v"(tid));
    const int lane0 = tid & 63, wid = __builtin_amdgcn_readfirstlane(tid >> 6), r32 = lane0 & 31, hi = lane0 >> 5;
    const int t0 = qb * 32, jd = t0 >> 6, jtop = 4 * (t0 >> 8) + 3; const size_t rowbase = (size_t)b * T; const int tq = t0 + r32;
    if (t0 < 256) {
        const int r = tid >> 4, j = tid & 15, t = t0 + r;
        if (j <= jtop) { const int n = t - 64 * j + 1; const unsigned long long m = n >= 64 ? ~0ull : (n <= 0 ? 0ull : ((1ull << n) - 1ull)); mask[(rowbase + t) * 64 + j] = m; }
        return false;
    }
    const size_t row = rowbase + tq;
    if (tid < 32) ((LAS unsigned*)(L + IL_CNT))[tid] = 0u;
    for (int i = tid; i < 32 * HSTR * 4 / 16; i += 512) ((LAS u32x4*)(L + IL_HIST))[i] = (u32x4){0u, 0u, 0u, 0u};
    for (int i = tid; i < (IL_END - IL_MASK) / 16; i += 512) ((LAS u32x4*)(L + IL_MASK))[i] = (u32x4){0u, 0u, 0u, 0u};
    { const int rr = tid & 31;
#pragma unroll
      for (int k = 0; k < 2; ++k) { const int p = (tid >> 5) + 16 * k; *(LAS u32x4*)(L + IL_QF + p * 512 + rr * 16) = *(const u32x4*)(QI + (rowbase + t0 + rr) * 256 + 8 * p); } }
    const f32x4 w = *(const f32x4*)(WI + row * 4);
    const bf16_t* KIb = KI + rowbase * 64;
    __syncthreads();
    bf16x8 qf[16];
#pragma unroll
    for (int i = 0; i < 16; ++i) qf[i] = *(const LAS bf16x8*)(L + IL_QF + (i * 2 + hi) * 512 + r32 * 16);
    idx_pass<1>(KIb, qf, w, jd, tq, wid, r32, hi, 0u, 0u, false, L);
    __syncthreads();
    { const int sr = tid >> 4, sq = tid & 15, b0 = NBINS - 20 - 20 * sq; const LAS unsigned* H = (const LAS unsigned*)(L + IL_HIST) + sr * HSTR + b0;
      unsigned c[20], ssum = 0u;
#pragma unroll
      for (int i = 0; i < 20; ++i) { c[i] = H[i]; ssum += c[i]; }
      unsigned incl = ssum;
#pragma unroll
      for (int o = 1; o < 16; o <<= 1) { const unsigned v = shfl_up_u(incl, o, lane0); if (sq >= o) incl += v; }
      unsigned cum = incl - ssum;
      if (cum < 256u && incl >= 256u) { bool found = false; int tb = 0; unsigned nd = 0u, ct = 0u;
#pragma unroll
          for (int i = 19; i >= 0; --i) { if (!found && cum + c[i] >= 256u) { found = true; tb = b0 + i; nd = 256u - cum; ct = c[i]; } cum += c[i]; }
          ((LAS unsigned*)(L + IL_TABN))[sr] = ct; ((LAS unsigned*)(L + IL_TABNEED))[sr] = nd; ((LAS unsigned*)(L + IL_TABBIN))[sr] = (unsigned)tb; } }
    __syncthreads();
    const int thrbin = (int)((const LAS unsigned*)(L + IL_TABBIN))[r32]; const unsigned cthr = ((const LAS unsigned*)(L + IL_TABN))[r32];
    const bool ovf = (thrbin != ZBIN) && cthr > (unsigned)IDX_CAP;
    if (__builtin_amdgcn_ballot_w64(ovf) != 0ull) return true;
    idx_pass<2>(KIb, qf, w, jd, tq, wid, r32, hi, keylo(thrbin + 1), keylo(thrbin), thrbin != ZBIN, L);
    __syncthreads();
    asm volatile("" : "+v"(tid));
    const int lane = tid & 63;
    for (int q = 0; q < 4; ++q) { const int r = 4 * wid + q; const int n = (int)((const LAS unsigned*)(L + IL_TABN))[r]; const unsigned nd = ((const LAS unsigned*)(L + IL_TABNEED))[r];
        const bool zrow = ((const LAS unsigned*)(L + IL_TABBIN))[r] == (unsigned)ZBIN;
        if (zrow) {
            const unsigned long long z = ((const LAS unsigned long long*)(L + IL_Z))[r * 64 + lane]; const unsigned c = (unsigned)__builtin_popcountll(z);
            unsigned incl = c;
#pragma unroll
            for (int o = 1; o < 64; o <<= 1) { const unsigned v = shfl_up_u(incl, o, lane); if (lane >= o) incl += v; }
            const unsigned excl = incl - c; unsigned long long take = 0ull;
            if (incl <= nd) take = z;
            else if (excl < nd) { unsigned long long zz = z; for (unsigned k = nd - excl; k > 0u; --k) { const unsigned long long low = zz & (0ull - zz); take |= low; zz ^= low; } }
            if (take) ((LAS unsigned long long*)(L + IL_MASK))[r * 64 + lane] |= take;
        } else {
            LAS unsigned long long* cc = (LAS unsigned long long*)(L + IL_CAND) + r * IDX_CAP;
            const int nc = (n + 63) >> 6;
            if (nc <= 1) idx_rank<1>(cc, n, nd, lane, (LAS unsigned*)(L + IL_MASK) + r * 128); else if (nc == 2) idx_rank<2>(cc, n, nd, lane, (LAS unsigned*)(L + IL_MASK) + r * 128); else idx_rank<3>(cc, n, nd, lane, (LAS unsigned*)(L + IL_MASK) + r * 128);
        }
    }
    __syncthreads();
    { const int r = tid >> 4; const LAS unsigned long long* ML = (const LAS unsigned long long*)(L + IL_MASK) + r * 64; unsigned long long* MG = mask + (rowbase + t0 + r) * 64;
      for (int j = 2 * (tid & 15); j <= jtop; j += 32) { const unsigned long long w0 = ML[j], w1 = ML[j + 1]; st16_wt(MG + j, (u32x4){(unsigned)w0, (unsigned)(w0 >> 32), (unsigned)w1, (unsigned)(w1 >> 32)}); } }
    __syncthreads();
    return false;
}

template <int WND> __device__ __forceinline__ void pool_ld(u32x4 (&v)[WND], const bf16_t* U, int row, int ch8) {
    const int t = row % T;
#pragma unroll
    for (int i = 0; i < WND; ++i) { const int ri = i <= t ? i : t; v[i] = *(const u32x4*)(U + (size_t)(row - ri) * 512 + ch8 * 8); }
}
template <int WND> __device__ __forceinline__ void pool_st(const u32x4 (&v)[WND], __amdgpu_buffer_rsrc_t mix, int row, int ch8) {
    const int t = row % T; const int cnt = (t + 1 < WND) ? t + 1 : WND;
    float acc[8], cur[8];
#pragma unroll
    for (int e = 0; e < 8; ++e) acc[e] = 0.f;
#pragma unroll
    for (int i = 0; i < WND; ++i) {
#pragma unroll
        for (int e = 0; e < 4; ++e) { const unsigned wv = (i < cnt) ? v[i][e] : 0u; const float a = __uint_as_float(wv << 16), bq = __uint_as_float(wv & 0xFFFF0000u); acc[2 * e] += a; acc[2 * e + 1] += bq; if (i == 0) { cur[2 * e] = a; cur[2 * e + 1] = bq; } } }
    const float fc = (float)cnt; u32x4 o;
#pragma unroll
    for (int e = 0; e < 4; ++e) o[e] = pk2(acc[2 * e] / fc - cur[2 * e], acc[2 * e + 1] / fc - cur[2 * e + 1]);
    __builtin_amdgcn_raw_buffer_store_b128(o, mix, (row * D + 512 + ch8 * 8) * 2, 0, 16);
}
__device__ __forceinline__ void pool_rows(int row0, int nrows, const bf16_t* U, bf16_t* MIX, int tid) {
    const __amdgpu_buffer_rsrc_t mix = __builtin_amdgcn_make_buffer_rsrc((void*)MIX, 0, 0x7FFFFFFF, 0x00020000);
    const int w = __builtin_amdgcn_readfirstlane(tid >> 6), lane = tid & 63, chl = lane & 15;
    const int r0 = row0 + 8 * w + (lane >> 4), r1 = r0 + 4;
    u32x4 A[16], B[8], C[4], E2[2];
    pool_ld<16>(A, U, r0, 48 + chl);
    pool_ld<8>(B, U, r0, 32 + chl);  pool_st<16>(A, mix, r0, 48 + chl);
    pool_ld<4>(C, U, r0, 16 + chl);  pool_st<8>(B, mix, r0, 32 + chl);
    pool_ld<2>(E2, U, r0, chl);      pool_st<4>(C, mix, r0, 16 + chl);
    pool_ld<16>(A, U, r1, 48 + chl); pool_st<2>(E2, mix, r0, chl);
    pool_ld<8>(B, U, r1, 32 + chl);  pool_st<16>(A, mix, r1, 48 + chl);
    pool_ld<4>(C, U, r1, 16 + chl);  pool_st<8>(B, mix, r1, 32 + chl);
    pool_ld<2>(E2, U, r1, chl);      pool_st<4>(C, mix, r1, 16 + chl);
    pool_st<2>(E2, mix, r1, chl);
}

#ifndef REP_E2
#define REP_E2 1
#endif
#ifndef REP_E3
#define REP_E3 1
#endif
#ifndef REP_O2
#define REP_O2 1
#endif
#ifndef REP_G1
#define REP_G1 1
#endif
#ifndef REP_UP
#define REP_UP 1
#endif
#ifndef REP_DN
#define REP_DN 1
#endif
#ifndef REP_PRO
#define REP_PRO 1
#endif
#ifndef REP_QKV
#define REP_QKV 1
#endif
#ifndef REP_OUT
#define REP_OUT 1
#endif
extern __shared__ __attribute__((aligned(16))) unsigned char lds_raw[];
#define LDS0 ((LAS unsigned char*)lds_raw)
constexpr int CTL_MFLAG = 8192;
__device__ __forceinline__ void mflag_publish(int b, int qb, unsigned tag, int wave_s) {
    asm volatile("s_waitcnt vmcnt(0)" ::: "memory");
    __syncthreads();
    if (wave_s == 0 && lane_id() == 0) {
        __builtin_amdgcn_fence(__ATOMIC_RELEASE, "agent");
        asm volatile("s_waitcnt vmcnt(0)" ::: "memory");
        __hip_atomic_store((unsigned*)(karg_ws() + WS_CTL) + CTL_MFLAG + 16 * (128 * b + qb), tag, __ATOMIC_RELAXED, __HIP_MEMORY_SCOPE_AGENT);
    }
}
__device__ __forceinline__ void mflag_wait(int b, int m64, unsigned tag, int wave_s) {
    if (wave_s == 0 && lane_id() == 0) {
        unsigned* bar = (unsigned*)(karg_ws() + WS_CTL) + 4096; unsigned* f = (unsigned*)(karg_ws() + WS_CTL) + CTL_MFLAG + 16 * (128 * b + 2 * m64);
        XB_SPIN(xb_ld(f) < tag || xb_ld(f + 16) < tag, bar);
        __builtin_amdgcn_fence(__ATOMIC_ACQUIRE, "agent");
        asm volatile("s_waitcnt vmcnt(0)" ::: "memory");
    }
    __syncthreads();
}
__device__ __forceinline__ void grid_barrier(int wave_s) {
    XcdBarrier b; b.bar = (unsigned*)(karg_ws() + WS_CTL) + 4096; b.x = xb_xcc_id(); b.st = (volatile LAS unsigned*)(LDS0 + MISC_OFF) + 8;
    xcd_barrier_impl(b, wave_s == 0 && lane_id() == 0);
}
__device__ __forceinline__ Frame make_frame(int wave_s) {
    Frame F; F.lds = LDS0; { int t_ = wave_s * 64 + lane_id(); asm volatile("" : "+v"(t_)); F.tid = t_; } F.lane = F.tid & 63; F.wave = wave_s;
    F.G = gridDim.x; { const int bx = blockIdx.x; F.vcu = (F.G % 8 == 0) ? (bx % 8) * (F.G / 8) + bx / 8 : bx; }
    return F;
}
template <class Epi> __device__ __forceinline__ void run_gemm(const pg8::Gemm& g, const Epi& E, int wave_s, bool half_tail = false) {
    pg8::StaticOrder S; S.init(M, g.N, (int)gridDim.x, (int)blockIdx.x);
    if (half_tail && S.nwg % S.G == S.G / 2) S.htail = S.nwg / S.G;
    pg8::gemm_phase<Epi, true, true>(LDS0, (LAS float*)(LDS0 + TAB_OFF), g, S, E, wave_s);
}

__global__ void __launch_bounds__(512, 2) trunk_fwd(Args args) {
    const int wave_s = __builtin_amdgcn_readfirstlane((int)threadIdx.x >> 6);
    {
        LAS unsigned char* lds0 = LDS0;
        for (int u = wave_s * 64 + lane_id(); u < (LDS_BYTES - LDSCTL_OFF) / 4; u += 512) ((LAS unsigned*)(lds0 + LDSCTL_OFF))[u] = 0u;
        __syncthreads();
        if (wave_s == 0 && lane_id() == 0) (void)xb_add(&((unsigned*)(karg_ws() + WS_CTL) + 4096)[XB_XCNT(xb_xcc_id())], 1u);
    }
#ifndef NO_PRO
    for (int rep_ = 0; rep_ < REP_PRO; ++rep_) { const Frame F = make_frame(wave_s); p0_prologue(F); }
#endif
    grid_barrier(wave_s);

#pragma unroll 1
    for (int layer = 0; layer < DEPTH; ++layer) {
        const int li = layer >> 1;
        if ((layer & 1) == 0) {
            { unsigned char* ws = karg_ws();
              pg8::Gemm g{(const bf16_t*)(ws + WS_XB), (const bf16_t*)(ws + WS_W_EIN + li * SZ_EIN), EIN, D, D, (const float*)(ws + WS_SSP)};
              pg8::EpiEvenIn E{ws, karg_in<5>() + li * 64, karg_in<6>() + li * 64};
#ifndef NO_G1
              for (int rep_ = 0; rep_ < REP_G1; ++rep_) run_gemm(g, E, wave_s);
#endif
            }
            grid_barrier(wave_s);
            { const Frame F = make_frame(wave_s); unsigned char* ws = karg_ws(); const int c = F.vcu; const int b = c >> 6, i = c & 63;
#ifndef NO_IDX
              if (F.G == 256) for (int rep_ = 0; rep_ < REP_E2; ++rep_) {
#pragma unroll 1
                  for (int k = 0; k < 2; ++k) { const int qb = k ? i : 127 - i;
                      const bool fb = idx_unit_fast(b, qb, (const bf16_t*)(ws + WS_EQI), (const bf16_t*)(ws + WS_EKI), (const float*)(ws + WS_EWI), (unsigned long long*)(ws + WS_MASK), F.lds, F.tid);
                      if (fb) idx_unit(b, qb, (const bf16_t*)(ws + WS_EQI), (const bf16_t*)(ws + WS_EKI), (const float*)(ws + WS_EWI), (unsigned long long*)(ws + WS_MASK), (LAS unsigned*)F.lds, F.tid);
                      mflag_publish(b, qb, (unsigned)li + 1u, wave_s); }
              }
#endif
#ifndef NO_POOL
              for (int r0 = c * 64; r0 < M; r0 += F.G * 64) pool_rows(r0, 64, (const bf16_t*)(ws + WS_EU), (bf16_t*)(ws + WS_EMIX), F.tid);
#endif
            }
            __syncthreads();
#ifndef NO_DSA
            { const Frame F = make_frame(wave_s); unsigned char* ws = karg_ws(); LAS char* wl = (LAS char*)(F.lds + F.wave * WL_STRIDE); const int gw = F.vcu * 8 + F.wave, NGW = F.G * 8;
              float sbound;
              { float mq = __builtin_fabsf((karg_in<5>() + li * 64)[F.lane]), mk = __builtin_fabsf((karg_in<6>() + li * 64)[F.lane]);
#pragma unroll
                for (int o_ = 1; o_ < 64; o_ <<= 1) { mq = __builtin_fmaxf(mq, shfl_xor_f(mq, o_, F.lane)); mk = __builtin_fmaxf(mk, shfl_xor_f(mk, o_, F.lane)); }
                sbound = 64.0f * C2 * 1.03f * mq * mk; if (!(sbound <= 24.0f)) sbound = -1.0f; }
              if (F.tid < 64) { const int n_ = F.tid >> 2, e_ = F.tid & 3;
                  ((LAS unsigned*)(F.lds + DL_T))[F.tid] = ((n_ >> e_) & 1) ? __float_as_uint(-sbound) : 0xFF800000u; }
              __syncthreads();
              for (int rep_ = 0; rep_ < REP_E3; ++rep_)
              for (int p = F.vcu; p < NB * 2 * 32; p += F.G) { const int bg = p >> 5, mm = p & 31;
                  mflag_wait(bg >> 1, 63 - mm, (unsigned)li + 1u, wave_s);
                  dsa_block_unit(bg >> 1, bg & 1, 63 - mm, (const bf16_t*)(ws + WS_EQ), (const bf16_t*)(ws + WS_EK), (const bf16_t*)(ws + WS_EV), (const unsigned long long*)(ws + WS_MASK), (bf16_t*)(ws + WS_EMIX), (LAS char*)F.lds, F.wave, F.lane, sbound);
                  mflag_wait(bg >> 1, mm, (unsigned)li + 1u, wave_s);
                  dsa_block_unit(bg >> 1, bg & 1, mm, (const bf16_t*)(ws + WS_EQ), (const bf16_t*)(ws + WS_EK), (const bf16_t*)(ws + WS_EV), (const unsigned long long*)(ws + WS_MASK), (bf16_t*)(ws + WS_EMIX), (LAS char*)F.lds, F.wave, F.lane, sbound); } }
#endif
            grid_barrier(wave_s);
            { unsigned char* ws = karg_ws(); float* OUT = karg_out();
              pg8::Gemm g{(const bf16_t*)(ws + WS_EMIX), (const bf16_t*)(ws + WS_W_EOUT + li * SZ_SQ), D, D, D, nullptr};
              pg8::EpiRes E{(layer == 0) ? karg_in<0>() : (const float*)nullptr, (float*)nullptr, ws, false};
#ifndef NO_GRES
              for (int rep_ = 0; rep_ < REP_OUT; ++rep_) { E.dry = rep_ + 1 < REP_OUT; run_gemm(g, E, wave_s); }
#endif
            }
            grid_barrier(wave_s);
        } else {
            { const Frame F = make_frame(wave_s); quant_rows(karg_ws(), WS_XQ1, WS_SAR1, F.vcu * 8 + F.wave, F.G * 8, F.lane); }
            grid_barrier(wave_s);
            { unsigned char* ws = karg_ws();
              pg8::Gemm g{(const bf16_t*)(ws + WS_XQ1), (const bf16_t*)(ws + WS_W_OQKV + li * SZ_OQKV), 3 * D, D / 2, D / 2, (const float*)(ws + WS_SAR1)};
              pg8::EpiOddQKVq E{(bf16_t*)(ws + WS_OQ), (const float*)(ws + WS_SWQ) + (size_t)li * 3 * D};
#ifndef NO_GQKV
              for (int rep_ = 0; rep_ < REP_QKV; ++rep_) run_gemm(g, E, wave_s);
#endif
            }
            grid_barrier(wave_s);
#ifndef NO_SB
            { const Frame F = make_frame(wave_s); unsigned char* ws = karg_ws(); LAS char* wl = (LAS char*)(F.lds + F.wave * WL_STRIDE); const int gw = F.vcu * 8 + F.wave, NGW = F.G * 8;
              for (int rep_ = 0; rep_ < REP_O2; ++rep_)
              { bf16x8 qr[4]; int u = F.vcu;
                { const int u0 = u < NB * 8 * 32 ? u : 0;
                  sb_prefetch(qr, u0 >> 8, (u0 >> 5) & 7, u0 & 31, (const bf16_t*)(ws + WS_OQ), (const bf16_t*)(ws + WS_OK), (const bf16_t*)(ws + WS_OV), (LAS char*)F.lds, F.wave, F.lane); }
                for (; u < NB * 8 * 32; u += F.G) { const int bh = u >> 5, ub = u & 31; const int un = u + F.G; const bool hn = un < NB * 8 * 32;
                    sb_block_unit(qr, bh >> 3, bh & 7, ub, hn ? (un >> 8) : -1, (un >> 5) & 7, un & 31, (const bf16_t*)(ws + WS_OQ), (const bf16_t*)(ws + WS_OK), (const bf16_t*)(ws + WS_OV), (bf16_t*)(ws + WS_OQ), (LAS char*)F.lds, F.wave, F.lane); } } }
#endif
            grid_barrier(wave_s);
            { unsigned char* ws = karg_ws(); float* OUT = karg_out();
              pg8::Gemm g{(const bf16_t*)(ws + WS_OQ), (const bf16_t*)(ws + WS_W_OOUT + li * SZ_SQ), D, D, D, nullptr};
              pg8::EpiRes E{(const float*)nullptr, (float*)nullptr, ws, false};
#ifndef NO_GRES
              for (int rep_ = 0; rep_ < REP_OUT; ++rep_) { E.dry = rep_ + 1 < REP_OUT; run_gemm(g, E, wave_s); }
#endif
            }
            grid_barrier(wave_s);
        }
        { const Frame F = make_frame(wave_s); quant_rows(karg_ws(), WS_XQ, WS_SAR, F.vcu * 8 + F.wave, F.G * 8, F.lane); }
        grid_barrier(wave_s);
        { unsigned char* ws = karg_ws();
          pg8::Gemm g{(const bf16_t*)(ws + WS_XQ), (const bf16_t*)(ws + WS_W_UP + layer * SZ_UP), 2 * FF, D / 2, D / 2, (const float*)(ws + WS_SAR)};
          pg8::EpiSwiGLUq E{(bf16_t*)(ws + WS_H2), (const float*)(ws + WS_SW) + (size_t)layer * 2 * FF};
#ifndef NO_GUP
          for (int rep_ = 0; rep_ < REP_UP; ++rep_) run_gemm(g, E, wave_s, true);
#endif
        }
        grid_barrier(wave_s);
        { unsigned char* ws = karg_ws(); float* OUT = karg_out();
          pg8::Gemm g{(const bf16_t*)(ws + WS_H2), (const bf16_t*)(ws + WS_W_DN + layer * SZ_DN), D, FF, FF, nullptr};
          pg8::EpiRes E{(const float*)nullptr, (layer + 1 == DEPTH) ? OUT : (float*)nullptr, ws, false};
#ifndef NO_GRES
          for (int rep_ = 0; rep_ < REP_DN; ++rep_) { E.dry = rep_ + 1 < REP_DN; run_gemm(g, E, wave_s); }
#endif
        }
        if (layer + 1 < DEPTH) grid_barrier(wave_s);
    }
}

extern "C" void kernel_launch(void* const* d_in, const int* in_sizes, int n_in, void* d_out, int out_size, void* d_ws, size_t ws_size, hipStream_t stream) {
    static int grid = 0;
    if (grid == 0) {
        if (n_in != 14 || in_sizes[0] != M * D || out_size != M * D || ws_size < WS_END) { fprintf(stderr, "kernel_launch: unexpected shapes (n_in %d in0 %d out %d ws %zu); nothing launched\n", n_in, n_in > 0 ? in_sizes[0] : -1, out_size, ws_size); grid = -1; return; }
        int dev = 0, cus = 0, per_cu = 0;
        if (hipGetDevice(&dev) != hipSuccess || hipDeviceGetAttribute(&cus, hipDeviceAttributeMultiprocessorCount, dev) != hipSuccess) { grid = -1; return; }
        if (hipFuncSetAttribute((const void*)trunk_fwd, hipFuncAttributeMaxDynamicSharedMemorySize, LDS_BYTES) != hipSuccess) { fprintf(stderr, "kernel_launch: hipFuncSetAttribute failed\n"); grid = -1; return; }
        if (hipOccupancyMaxActiveBlocksPerMultiprocessor(&per_cu, (const void*)trunk_fwd, 512, LDS_BYTES) != hipSuccess || per_cu < 1) fprintf(stderr, "kernel_launch: occupancy query reports %d\n", per_cu);
        (void)hipGetLastError();
        grid = cus;
    }
    if (grid < 0) return;
    if (hipMemsetAsync((char*)d_ws + WS_CTL, 0, CTL_ZERO_BYTES, stream) != hipSuccess) return;
    Args a{};
    for (int i = 0; i < 14; ++i) a.in[i] = (const float*)d_in[i];
    a.out = (float*)d_out; a.ws = (unsigned char*)d_ws;
    hipLaunchKernelGGL(trunk_fwd, dim3(grid), dim3(512), LDS_BYTES, stream, a);
}
```
